# Optimizing an MI355X kernel written in HIP

```python
import jax, jax.numpy as jnp
from jax import lax
import numpy as np

D_MODEL = 2048
BATCH = 2
SEQ = 8192
DEPTH = 1

N_META = 16
CHUNK = 64
N_HEADS_A = 8
HEAD_DIM_K = 128
HEAD_DIM_V = 128
QK_DIM = N_HEADS_A * HEAD_DIM_K
V_DIM = N_HEADS_A * HEAD_DIM_V
CONV_K = 4
POOL_WINDOWS = (2, 4, 8, 16)
N_POOL_GROUPS = 4
POOL_GROUP_DIM = 256
POOL_DIM = N_POOL_GROUPS * POOL_GROUP_DIM
FFN_DIM = -(-(8 * D_MODEL) // (3 * 256)) * 256
RMS_EPS = 1e-6
L2_EPS = 1e-6
IN_SIZES = (QK_DIM, QK_DIM, V_DIM, V_DIM, N_HEADS_A, N_HEADS_A, POOL_DIM, D_MODEL, D_MODEL)
IN_DIM = QK_DIM * 2 + V_DIM * 2 + N_HEADS_A * 2 + POOL_DIM + D_MODEL * 2

kernel_name = 'hybrid_gated_deltanet_multiscale_pool_block'


def rms_norm(x, w):
    xf = x.astype(jnp.float32)
    y = xf * lax.rsqrt(jnp.mean(xf * xf, axis=-1, keepdims=True) + RMS_EPS)
    return (y * w.astype(jnp.float32)).astype(x.dtype)


def l2_norm(x):
    return x * lax.rsqrt(jnp.sum(x * x, axis=-1, keepdims=True) + L2_EPS)


def causal_dwconv(x, w):
    return lax.conv_general_dilated(
        x, w.astype(x.dtype)[:, None, :], window_strides=(1,), padding=[(CONV_K - 1, 0)],
        dimension_numbers=('NWC', 'WIO', 'NWC'), feature_group_count=x.shape[-1])


def gated_delta_rule_chunked(q, k, v, beta, g):
    B, T, H, DK = q.shape
    DV = v.shape[-1]
    N = T // CHUNK

    def to_chunks(a):
        return a.reshape(B, N, CHUNK, H, a.shape[-1]).transpose(0, 1, 3, 2, 4)

    qc = to_chunks(q * (DK ** -0.5))
    kc = to_chunks(k)
    vc = to_chunks(v)
    bc = beta.reshape(B, N, CHUNK, H).transpose(0, 1, 3, 2)
    gc = jnp.cumsum(g.reshape(B, N, CHUNK, H).transpose(0, 1, 3, 2), axis=-1)

    incl = jnp.tril(jnp.ones((CHUNK, CHUNK), dtype=bool))
    strict = jnp.tril(jnp.ones((CHUNK, CHUNK), dtype=bool), k=-1)
    diff = gc[..., :, None] - gc[..., None, :]
    decay = jnp.exp(jnp.where(incl, diff, -jnp.inf))

    kb = kc * bc[..., None]
    a_mat = jnp.where(strict, jnp.einsum('bnhid,bnhjd->bnhij', kb, kc) * decay, 0.0)
    eye = jnp.broadcast_to(jnp.eye(CHUNK, dtype=jnp.float32), a_mat.shape)
    t_mat = lax.linalg.triangular_solve(a_mat, eye, left_side=True, lower=True, unit_diagonal=True)
    u = jnp.einsum('bnhij,bnhjd->bnhid', t_mat, vc * bc[..., None])
    w = jnp.einsum('bnhij,bnhjd->bnhid', t_mat, kb * jnp.exp(gc)[..., None])
    qk = jnp.einsum('bnhid,bnhjd->bnhij', qc, kc) * decay
    q_dec = qc * jnp.exp(gc)[..., None]
    k_dec = kc * jnp.exp(gc[..., -1:] - gc)[..., None]
    g_last = jnp.exp(gc[..., -1])

    def step(state, inp):
        u_n, w_n, qk_n, qd_n, kd_n, gl_n = inp
        v_new = u_n - jnp.einsum('bhcd,bhde->bhce', w_n, state)
        o_n = jnp.einsum('bhcd,bhde->bhce', qd_n, state) + jnp.einsum('bhij,bhje->bhie', qk_n, v_new)
        state = state * gl_n[..., None, None] + jnp.einsum('bhcd,bhce->bhde', kd_n, v_new)
        return state, o_n

    xs = tuple(jnp.moveaxis(a, 1, 0) for a in (u, w, qk, q_dec, k_dec, g_last))
    s0 = jnp.zeros((B, H, DK, DV), jnp.float32)
    _, o = lax.scan(step, s0, xs)
    return o.transpose(1, 0, 3, 2, 4).reshape(B, T, H, DV)


def causal_multiscale_pool(p):
    B, L, _ = p.shape
    pg = p.reshape(B, L, N_POOL_GROUPS, POOL_GROUP_DIM)
    csum = jnp.cumsum(pg, axis=1)
    t = jnp.arange(L)
    outs = []
    for gi, win in enumerate(POOL_WINDOWS):
        cg = csum[:, :, gi]
        shifted = jnp.pad(cg[:, :L - win], ((0, 0), (win, 0), (0, 0)))
        count = jnp.minimum(t + 1, win).astype(jnp.float32)[None, :, None]
        outs.append((cg - shifted) / count - pg[:, :, gi])
    return jnp.stack(outs, axis=2)


def hybrid_mixer(hn, w_in, conv_w, a_log, dt_bias, o_norm_w, w_proj_a, pool_w, pool_scale, w_proj_b, w_out):
    B, L, _ = hn.shape
    dt = hn.dtype
    split_idx = np.cumsum(IN_SIZES)[:-1].tolist()
    proj = hn @ w_in
    q, k, v, z, b_logit, a_logit, p, gate_a, gate_b = jnp.split(proj, split_idx, axis=-1)

    qkv = jax.nn.silu(causal_dwconv(jnp.concatenate([q, k, v], axis=-1), conv_w)).astype(jnp.float32)
    q, k, v = jnp.split(qkv, [QK_DIM, 2 * QK_DIM], axis=-1)
    q = l2_norm(q.reshape(B, L, N_HEADS_A, HEAD_DIM_K))
    k = l2_norm(k.reshape(B, L, N_HEADS_A, HEAD_DIM_K))
    v = v.reshape(B, L, N_HEADS_A, HEAD_DIM_V)
    beta = jax.nn.sigmoid(b_logit.astype(jnp.float32))
    g = -jnp.exp(a_log.astype(jnp.float32)) * jax.nn.softplus(
        a_logit.astype(jnp.float32) + dt_bias.astype(jnp.float32))
    pad = (-N_META) % CHUNK
    padt = lambda a: jnp.pad(a, ((0, 0), (pad, 0)) + ((0, 0),) * (a.ndim - 2))
    o = gated_delta_rule_chunked(padt(q), padt(k), padt(v), padt(beta), padt(g))[:, pad:]
    zf = z.astype(jnp.float32).reshape(B, L, N_HEADS_A, HEAD_DIM_V)
    o = o * lax.rsqrt(jnp.mean(o * o, axis=-1, keepdims=True) + RMS_EPS) * o_norm_w.astype(jnp.float32) * jax.nn.silu(zf)
    y_a = o.reshape(B, L, V_DIM).astype(dt) @ w_proj_a

    pooled = causal_multiscale_pool(p.astype(jnp.float32))
    zb = jnp.einsum('blgc,gcd->blgd', pooled, pool_w.astype(jnp.float32)).reshape(B, L, POOL_DIM)
    zb = zb * pool_scale.astype(jnp.float32)
    y_b = zb.astype(dt) @ w_proj_b

    merged = jax.nn.sigmoid(gate_a) * y_a + jax.nn.sigmoid(gate_b) * y_b
    return merged @ w_out


def swiglu_ffn(hn, w_gate, w_up, w_down):
    return (jax.nn.silu(hn @ w_gate) * (hn @ w_up)) @ w_down


def setup_inputs(seed: int = 0) -> dict:
    key = jax.random.key(seed)
    ks = jax.random.split(key, 20)
    f32 = jnp.float32
    nrm = lambda k, shape, scale: jax.random.normal(k, shape, f32) * scale
    gain = lambda k, shape: 1.0 + 0.02 * jax.random.normal(k, shape, f32)
    dt_init = jnp.exp(jax.random.uniform(ks[5], (DEPTH, N_HEADS_A), f32, np.log(1e-3), np.log(1e-1)))
    return {
        'x': nrm(ks[0], (BATCH, SEQ, D_MODEL), 1.0),
        'meta_tokens': nrm(ks[1], (N_META, D_MODEL), 1.0),
        'norm_mix_w': gain(ks[2], (DEPTH, D_MODEL)),
        'w_in': nrm(ks[3], (DEPTH, D_MODEL, IN_DIM), D_MODEL ** -0.5),
        'conv_w': nrm(ks[4], (DEPTH, CONV_K, 2 * QK_DIM + V_DIM), CONV_K ** -0.5),
        'a_log': jnp.log(jax.random.uniform(ks[6], (DEPTH, N_HEADS_A), f32, 1.0, 16.0)),
        'dt_bias': dt_init + jnp.log(-jnp.expm1(-dt_init)),
        'o_norm_w': gain(ks[7], (DEPTH, HEAD_DIM_V)),
        'w_proj_a': nrm(ks[8], (DEPTH, V_DIM, D_MODEL), V_DIM ** -0.5),
        'pool_w': nrm(ks[9], (DEPTH, N_POOL_GROUPS, POOL_GROUP_DIM, POOL_GROUP_DIM), POOL_GROUP_DIM ** -0.5),
        'pool_scale': gain(ks[10], (DEPTH, POOL_DIM)),
        'w_proj_b': nrm(ks[11], (DEPTH, POOL_DIM, D_MODEL), POOL_DIM ** -0.5),
        'w_out': nrm(ks[12], (DEPTH, D_MODEL, D_MODEL), D_MODEL ** -0.5),
        'norm_ffn_w': gain(ks[13], (DEPTH, D_MODEL)),
        'w_ffn_gate': nrm(ks[14], (DEPTH, D_MODEL, FFN_DIM), D_MODEL ** -0.5),
        'w_ffn_up': nrm(ks[15], (DEPTH, D_MODEL, FFN_DIM), D_MODEL ** -0.5),
        'w_ffn_down': nrm(ks[16], (DEPTH, FFN_DIM, D_MODEL), FFN_DIM ** -0.5),
        'norm_final_w': gain(ks[17], (D_MODEL,)),
    }


def reference(x, meta_tokens, norm_mix_w, w_in, conv_w, a_log, dt_bias, o_norm_w, w_proj_a, pool_w,
              pool_scale, w_proj_b, w_out, norm_ffn_w, w_ffn_gate, w_ffn_up, w_ffn_down, norm_final_w):
    B = x.shape[0]
    meta = jnp.broadcast_to(meta_tokens.astype(x.dtype)[None], (B, N_META, D_MODEL))
    h = jnp.concatenate([meta, x], axis=1)
    for l in range(DEPTH):
        h = h + hybrid_mixer(rms_norm(h, norm_mix_w[l]), w_in[l], conv_w[l], a_log[l], dt_bias[l], o_norm_w[l],
                             w_proj_a[l], pool_w[l], pool_scale[l], w_proj_b[l], w_out[l])
        h = h + swiglu_ffn(rms_norm(h, norm_ffn_w[l]), w_ffn_gate[l], w_ffn_up[l], w_ffn_down[l])
    h = rms_norm(h, norm_final_w)
    return h[:, N_META:]
```

```cpp
#include <hip/hip_runtime.h>
#include <hip/hip_cooperative_groups.h>
#include <cstdio>
#include <cstdint>
namespace cg = cooperative_groups;

#define LAS __attribute__((address_space(3)))
typedef unsigned short bf16_t;
typedef short bf16x8 __attribute__((ext_vector_type(8)));
typedef float f32x4 __attribute__((ext_vector_type(4)));
typedef float f32x2 __attribute__((ext_vector_type(2)));
typedef unsigned u32x4 __attribute__((ext_vector_type(4)));
typedef unsigned u32x2 __attribute__((ext_vector_type(2)));

#ifndef MK_MULTI
#define MK_MULTI 0
#endif

constexpr int D = 2048, SEQ = 8192, NMETA = 16, TB = 8256  , RPV = 2 * TB  , RP = 16640  , RR = 16384;
constexpr int NCH = 129, NH = 8, HD = 128, NUNIT = 2 * NCH * NH  , UNIT_EL = 36864;
constexpr int FFN = 5632, NIN = 9472;
constexpr float RMS_EPS = 1e-6f, L2_EPS = 1e-6f;
constexpr int NTHREADS = 512;
constexpr int LDS_BYTES = 147456;

constexpr size_t MiB = 1u << 20;
constexpr size_t WS_BA = 1 * MiB, WS_GL = 2 * MiB + 512 * 1024, WS_SS1 = 3 * MiB;
constexpr size_t WS_WIN = 8 * MiB, WS_WA = 45 * MiB, WS_WB = 49 * MiB, WS_POOLT = 53 * MiB;
constexpr size_t WS_WOUT = 54 * MiB, WS_WGU = 62 * MiB, WS_WD = 106 * MiB;
constexpr size_t WS_PREPB = 128 * MiB;
constexpr size_t WS_HN = 128 * MiB, WS_QKV = 200 * MiB, WS_Z = 298 * MiB, WS_P = 331 * MiB, WS_GAB = 364 * MiB;
constexpr size_t WS_O = 200 * MiB, WS_OG = 233 * MiB, WS_POOLED = 266 * MiB, WS_ZB = 128 * MiB, WS_MERGED = 160 * MiB, WS_H1B = 364 * MiB, WS_HIDDEN = 128 * MiB;
constexpr size_t WS_H2B = 428 * MiB;
constexpr size_t WS_WEFF = 494 * MiB;
constexpr size_t WS_END = 498 * MiB;
static_assert(WS_PREPB + (size_t)NUNIT * 12288 * 2 <= WS_QKV && (size_t)NUNIT * 24576 * 2 <= (size_t)RR * D * 4, "prep records");
static_assert(WS_GAB + (size_t)RP * 4096 * 2 <= WS_END, "gab");
static_assert(WS_HIDDEN + (size_t)RR * FFN * 2 <= WS_H1B, "hidden");

struct Params {
    const float* x; const float* meta; const float* norm_mix_w; const float* w_in; const float* conv_w; const float* a_log; const float* dt_bias; const float* o_norm_w;
    const float* w_proj_a; const float* pool_w; const float* pool_scale; const float* w_proj_b; const float* w_out; const float* norm_ffn_w; const float* w_gate; const float* w_up;
    const float* w_down; const float* norm_final_w;
    float* out; unsigned char* ws;
    long long phase_lo, phase_hi;
};

typedef __bf16 bf16x2_t __attribute__((ext_vector_type(2)));
__device__ __forceinline__ unsigned cvt_pk_bf16(float lo, float hi) { const f32x2 v = {lo, hi}; const bf16x2_t b = __builtin_convertvector(v, bf16x2_t); return __builtin_bit_cast(unsigned, b); }
__device__ __forceinline__ float bf_lo(unsigned w) { return __uint_as_float(w << 16); }
__device__ __forceinline__ float bf_hi(unsigned w) { return __uint_as_float(w & 0xffff0000u); }
__device__ __forceinline__ float fast_sigmoid(float x) { return __builtin_amdgcn_rcpf(1.0f + __expf(-x)); }
__device__ __forceinline__ float fast_silu(float x) { return x * fast_sigmoid(x); }
__device__ __forceinline__ float wave_sum(float v) {
#pragma unroll
    for (int o = 1; o < 64; o <<= 1) v += __shfl_xor(v, o);
    return v;
}
#define LDS_WAIT() asm volatile("s_waitcnt lgkmcnt(0)" ::: "memory")

namespace pg8 {
constexpr int BM = 256, BK = 64, HALF = 128, HTB = HALF * BK * 2, STAGE_BYTES = 8 * HTB, NXCD = 8, WGM = 8;
__host__ __device__ __forceinline__ int lds_byte(int r, int c) { const int st = (r >> 4) * 2 + (c >> 5), rr = r & 15, cc = c & 31, ob = rr * 64 + cc * 2; return st * 1024 + (ob ^ (((ob >> 9) & 1) << 5)); }
__host__ __device__ __forceinline__ void stage_rc(int b, int& R, int& C) { const int st = b / 1024, sb = b % 1024, swz = sb ^ (((sb >> 9) & 1) << 5); R = (st >> 1) * 16 + swz / 64; C = (st & 1) * 32 + (swz % 64) / 2; }
__host__ __device__ __forceinline__ int perm32(int rho) { const int n = rho >> 4, i = rho & 15; return 8 * (i >> 2) + 4 * n + (i & 3); }

struct Unit { int pm, pn; };
struct Gemm { const bf16_t* A; const bf16_t* Bt; int lda, ldb, K, a_pn_off; };

struct StaticOrder {
    int nM, nN, nwg, G, c;
    __device__ void init(int M, int N, int G_, int c_) { nM = M / BM; nN = N / BM; nwg = nM * nN; G = G_; c = c_; }
    __device__ bool next(int i, Unit& u) const {
        const long L = (long)i * G + c; if (L >= nwg) return false;
        int wgid = (int)L; { const int q = nwg / NXCD, r = nwg % NXCD, xcd = wgid % NXCD, off = wgid / NXCD; wgid = (xcd < r ? xcd * (q + 1) : r * (q + 1) + (xcd - r) * q) + off; }
        const int nig = WGM * nN, gid = wgid / nig, fm = gid * WGM, gsz = (nM - fm) < WGM ? (nM - fm) : WGM;
        u.pm = fm + ((wgid % nig) % gsz); u.pn = (wgid % nig) / gsz; return true;
    }
};

template <class Epi>
__device__ __forceinline__ void gemm_phase(LAS unsigned char* lds, const Gemm g, const StaticOrder& S, const Epi& E) {
    const int tid = threadIdx.x, wid = __builtin_amdgcn_readfirstlane(tid >> 6), lane = tid & 63, wr = wid >> 2, wc = wid & 3, fr = lane & 15, fq = lane >> 4;
    const int nt = g.K / BK;
    unsigned voffA[2], voffB[2];
#pragma unroll
    for (int i = 0; i < 2; ++i) { int R, C; stage_rc(tid * 16 + i * 8192, R, C); const int Rb = (R & ~31) + perm32(R & 31);
        voffA[i] = (unsigned)(R * g.lda + C) * 2u; voffB[i] = (unsigned)(Rb * g.ldb + C) * 2u; }
    const size_t kstep = (size_t)(BK * 2);
    const size_t hstepA = (size_t)HALF * g.lda * 2, hstepB = (size_t)HALF * g.ldb * 2;
    const unsigned ldsw = (unsigned)wid * 1024u;
    const int aoff = lds_byte(wr * 64 + fr, fq * 8), boff = lds_byte(wc * 32 + fr, fq * 8);
#define PG8_SA(b, h) (((b) * 2 + (h)) * HTB)
#define PG8_SB(b, h) ((4 + (b) * 2 + (h)) * HTB)
#define PG8_STAGE(bufoff, gbase, voff) do { _Pragma("unroll") for (int _i = 0; _i < 2; ++_i) \
        __builtin_amdgcn_global_load_lds((const unsigned*)((const char*)(gbase) + (voff)[_i]), (LAS unsigned*)(lds + (bufoff) + ldsw + _i * 8192), 16, 0, 0); } while (0)
#define PG8_LDA(dst, b, h) do { _Pragma("unroll") for (int m = 0; m < 4; ++m) _Pragma("unroll") for (int k = 0; k < 2; ++k) dst[m][k] = *(const LAS bf16x8*)(lds + PG8_SA(b, h) + aoff + m * 2048 + k * 1024); } while (0)
#define PG8_LDB(dst, b, h) do { _Pragma("unroll") for (int n = 0; n < 2; ++n) _Pragma("unroll") for (int k = 0; k < 2; ++k) dst[n][k] = *(const LAS bf16x8*)(lds + PG8_SB(b, h) + boff + n * 2048 + k * 1024); } while (0)
#define PG8_MMA(ai, bj, At, Bt) do { __builtin_amdgcn_s_setprio(1); _Pragma("unroll") for (int m = 0; m < 4; ++m) _Pragma("unroll") for (int n = 0; n < 2; ++n) _Pragma("unroll") for (int k = 0; k < 2; ++k) \
        acc[ai][bj][m][n] = __builtin_amdgcn_mfma_f32_16x16x32_bf16(Bt[n][k], At[m][k], acc[ai][bj][m][n], 0, 0, 0); __builtin_amdgcn_s_setprio(0); } while (0)
#define PG8_WAIT_V(n) asm volatile("s_waitcnt vmcnt(" #n ")" ::: "memory")
#define PG8_WAIT_L(n) asm volatile("s_waitcnt lgkmcnt(" #n ")" ::: "memory")
#define PG8_BAR __builtin_amdgcn_s_barrier()
#define PG8_SCHED __builtin_amdgcn_sched_barrier(0)
    Unit cur, nxt; int ui = 0;
    if (!S.next(0, cur)) return;
    f32x4 acc[2][2][4][2];
#pragma unroll
    for (int a = 0; a < 2; ++a)
#pragma unroll
        for (int b = 0; b < 2; ++b)
#pragma unroll
            for (int m = 0; m < 4; ++m)
#pragma unroll
                for (int n = 0; n < 2; ++n) acc[a][b][m][n] = (f32x4){0.f, 0.f, 0.f, 0.f};
    bf16x8 At[4][2], B0[2][2], B1[2][2];
    const char* cA = (const char*)g.A + (size_t)cur.pm * 2 * hstepA + (size_t)cur.pn * g.a_pn_off * 2; const char* cB = (const char*)g.Bt + (size_t)cur.pn * 2 * hstepB;
    PG8_STAGE(PG8_SB(0, 0), cB, voffB); PG8_STAGE(PG8_SB(0, 1), cB + hstepB, voffB); PG8_STAGE(PG8_SA(0, 0), cA, voffA); PG8_STAGE(PG8_SA(0, 1), cA + hstepA, voffA);
    if (wr == 1) PG8_BAR;
    PG8_WAIT_V(2); PG8_BAR;
    PG8_STAGE(PG8_SB(1, 0), cB + kstep, voffB); PG8_STAGE(PG8_SA(1, 0), cA + kstep, voffA); PG8_STAGE(PG8_SB(1, 1), cB + hstepB + kstep, voffB);
    PG8_WAIT_V(6); PG8_BAR;
    for (;;) {
        const bool has_next = S.next(ui + 1, nxt);
        const char* nA = has_next ? (const char*)g.A + (size_t)nxt.pm * 2 * hstepA + (size_t)nxt.pn * g.a_pn_off * 2 : cA; const char* nB = has_next ? (const char*)g.Bt + (size_t)nxt.pn * 2 * hstepB : cB;
#pragma unroll 1
        for (int t = 0; t < nt; t += 2) {
            const bool last = (t == nt - 2);
            const char* a1 = cA + (size_t)(t + 1) * kstep;
            const char* a2 = last ? nA : cA + (size_t)(t + 2) * kstep; const char* b2 = last ? nB : cB + (size_t)(t + 2) * kstep;
            const char* a3 = a2 + kstep; const char* b3 = b2 + kstep;
            PG8_LDB(B0, 0, 0); PG8_LDB(B1, 0, 1); PG8_SCHED; PG8_LDA(At, 0, 0); PG8_STAGE(PG8_SA(1, 1), a1 + hstepA, voffA);
            PG8_WAIT_V(8); PG8_WAIT_L(0); PG8_BAR; PG8_MMA(0, 0, At, B0); PG8_MMA(0, 1, At, B1); PG8_BAR; PG8_SCHED;
            PG8_LDA(At, 0, 1); PG8_STAGE(PG8_SB(0, 0), b2, voffB); PG8_STAGE(PG8_SB(0, 1), b2 + hstepB, voffB); PG8_STAGE(PG8_SA(0, 0), a2, voffA);
            PG8_WAIT_V(8); PG8_WAIT_L(0); PG8_BAR; PG8_MMA(1, 0, At, B0); PG8_MMA(1, 1, At, B1); PG8_BAR; PG8_SCHED;
            PG8_LDB(B0, 1, 0); PG8_LDB(B1, 1, 1); PG8_SCHED; PG8_LDA(At, 1, 0); PG8_STAGE(PG8_SA(0, 1), a2 + hstepA, voffA);
            PG8_WAIT_V(8); PG8_WAIT_L(0); PG8_BAR; PG8_MMA(0, 0, At, B0); PG8_MMA(0, 1, At, B1); PG8_BAR; PG8_SCHED;
            PG8_LDA(At, 1, 1); PG8_STAGE(PG8_SB(1, 0), b3, voffB); PG8_STAGE(PG8_SB(1, 1), b3 + hstepB, voffB); PG8_STAGE(PG8_SA(1, 0), a3, voffA);
            PG8_WAIT_V(8); PG8_WAIT_L(0); PG8_BAR; PG8_MMA(1, 0, At, B0); PG8_MMA(1, 1, At, B1); PG8_BAR; PG8_SCHED;
        }
        if (wr == 0) PG8_BAR;
        E(acc, cur, wr, wc, fr, fq);
        if (!has_next) break;
#pragma unroll
        for (int a = 0; a < 2; ++a)
#pragma unroll
            for (int b = 0; b < 2; ++b)
#pragma unroll
                for (int m = 0; m < 4; ++m)
#pragma unroll
                    for (int n = 0; n < 2; ++n) acc[a][b][m][n] = (f32x4){0.f, 0.f, 0.f, 0.f};
        cur = nxt; cA = nA; cB = nB; ++ui;
        if (wr == 1) PG8_BAR;
    }
    PG8_WAIT_V(0);
    PG8_BAR;
#undef PG8_SA
#undef PG8_SB
#undef PG8_STAGE
#undef PG8_LDA
#undef PG8_LDB
#undef PG8_MMA
#undef PG8_WAIT_V
#undef PG8_WAIT_L
#undef PG8_BAR
#undef PG8_SCHED
}

typedef f32x4 AccT[2][2][4][2];
template <int ACT  >
__device__ __forceinline__ void store_tile_bf16(const AccT& acc, bf16_t* base  , int ld, int row0) {
#pragma unroll
    for (int ai = 0; ai < 2; ++ai)
#pragma unroll
        for (int m = 0; m < 4; ++m) { bf16_t* rowp = base + (size_t)(row0 + ai * HALF + m * 16) * ld;
#pragma unroll
            for (int bj = 0; bj < 2; ++bj) { f32x4 v0 = acc[ai][bj][m][0], v1 = acc[ai][bj][m][1];
                if (ACT == 1) { for (int i = 0; i < 4; ++i) { v0[i] = fast_silu(v0[i]); v1[i] = fast_silu(v1[i]); } }
                if (ACT == 2) { for (int i = 0; i < 4; ++i) { v0[i] = fast_sigmoid(v0[i]); v1[i] = fast_sigmoid(v1[i]); } }
                u32x4 w; w.x = cvt_pk_bf16(v0[0], v0[1]); w.y = cvt_pk_bf16(v0[2], v0[3]); w.z = cvt_pk_bf16(v1[0], v1[1]); w.w = cvt_pk_bf16(v1[2], v1[3]);
                *(u32x4*)(rowp + bj * HALF) = w; } }
}
__device__ __forceinline__ unsigned q8(float x) { return (unsigned)(fast_sigmoid(x) * 255.0f + 0.5f); }
__device__ __forceinline__ void store_tile_gate_u8(const AccT& acc, unsigned char* base  , int row0) {
#pragma unroll
    for (int ai = 0; ai < 2; ++ai)
#pragma unroll
        for (int m = 0; m < 4; ++m) { unsigned char* rowp = base + (size_t)(row0 + ai * HALF + m * 16) * 4096;
#pragma unroll
            for (int bj = 0; bj < 2; ++bj) { const f32x4 v0 = acc[ai][bj][m][0], v1 = acc[ai][bj][m][1];
                u32x2 w; w.x = q8(v0[0]) | (q8(v0[1]) << 8) | (q8(v0[2]) << 16) | (q8(v0[3]) << 24); w.y = q8(v1[0]) | (q8(v1[1]) << 8) | (q8(v1[2]) << 16) | (q8(v1[3]) << 24);
                *(u32x2*)(rowp + bj * HALF) = w; } }
}
struct EpiIn {
    bf16_t* QKV; bf16_t* Z; bf16_t* P; unsigned char* GAB; float* BA;
    __device__ __forceinline__ void operator()(const AccT& acc, const Unit& u, int wr, int wc, int fr, int fq) const {
        const int pn = u.pn, row0 = u.pm * BM + wr * 64 + fr, cl = wc * 32 + 8 * fq;
        if (pn == 36) {
            if (wc == 0 && fq < 2) {
#pragma unroll
                for (int ai = 0; ai < 2; ++ai)
#pragma unroll
                    for (int m = 0; m < 4; ++m) { float* q = BA + (size_t)(row0 + ai * HALF + m * 16) * 16 + 8 * fq; *(f32x4*)q = acc[ai][0][m][0]; *(f32x4*)(q + 4) = acc[ai][0][m][1]; }
            }
            return;
        }
        if (pn < 12) store_tile_bf16<0>(acc, QKV + pn * 256 + cl, 3072, row0);
        else if (pn < 16) store_tile_bf16<1>(acc, Z + (pn - 12) * 256 + cl, 1024, row0);
        else if (pn < 20) store_tile_bf16<0>(acc, P + (pn - 16) * 256 + cl, 1024, row0);
        else store_tile_gate_u8(acc, GAB + (pn - 20) * 256 + cl, row0);
    }
};
struct EpiPlain {
    bf16_t* O; int ld;
    __device__ __forceinline__ void operator()(const AccT& acc, const Unit& u, int wr, int wc, int fr, int fq) const {
        store_tile_bf16<0>(acc, O + u.pn * 256 + wc * 32 + 8 * fq, ld, u.pm * BM + wr * 64 + fr);
    }
};
template <bool SECOND> struct EpiMerge {
    const unsigned char* GAB; bf16_t* MERGED;
    __device__ __forceinline__ void operator()(const AccT& acc, const Unit& u, int wr, int wc, int fr, int fq) const {
        const int row0 = u.pm * BM + wr * 64 + fr, cl = u.pn * 256 + wc * 32 + 8 * fq;
#pragma unroll
        for (int ai = 0; ai < 2; ++ai)
#pragma unroll
            for (int m = 0; m < 4; ++m) { const int rr = row0 + ai * HALF + m * 16; const int prow = rr + 64 + ((rr >> 13) << 6);
                const unsigned char* gp = GAB + (size_t)prow * 4096 + (SECOND ? 2048 : 0) + cl; bf16_t* mp = MERGED + (size_t)rr * 2048 + cl;
#pragma unroll
                for (int bj = 0; bj < 2; ++bj) { const u32x2 gw = *(const u32x2*)(gp + bj * HALF); const f32x4 v0 = acc[ai][bj][m][0] * (1.0f / 255.0f), v1 = acc[ai][bj][m][1] * (1.0f / 255.0f);
                    float r0 = (float)(gw.x & 0xffu) * v0[0], r1 = (float)((gw.x >> 8) & 0xffu) * v0[1], r2 = (float)((gw.x >> 16) & 0xffu) * v0[2], r3 = (float)(gw.x >> 24) * v0[3];
                    float r4 = (float)(gw.y & 0xffu) * v1[0], r5 = (float)((gw.y >> 8) & 0xffu) * v1[1], r6 = (float)((gw.y >> 16) & 0xffu) * v1[2], r7 = (float)(gw.y >> 24) * v1[3];
                    if (SECOND) { const u32x4 mw = *(const u32x4*)(mp + bj * HALF);
                        r0 += bf_lo(mw.x); r1 += bf_hi(mw.x); r2 += bf_lo(mw.y); r3 += bf_hi(mw.y); r4 += bf_lo(mw.z); r5 += bf_hi(mw.z); r6 += bf_lo(mw.w); r7 += bf_hi(mw.w); }
                    u32x4 w; w.x = cvt_pk_bf16(r0, r1); w.y = cvt_pk_bf16(r2, r3); w.z = cvt_pk_bf16(r4, r5); w.w = cvt_pk_bf16(r6, r7);
                    *(u32x4*)(mp + bj * HALF) = w; } }
    }
};
struct EpiOut {
    const float* x; bf16_t* H1B; float* SS1;
    __device__ __forceinline__ void operator()(const AccT& acc, const Unit& u, int wr, int wc, int fr, int fq) const {
        const int row0 = u.pm * BM + wr * 64 + fr, cl = u.pn * 256 + wc * 32 + 8 * fq;
#pragma unroll
        for (int ai = 0; ai < 2; ++ai)
#pragma unroll
            for (int m = 0; m < 4; ++m) { const int rr = row0 + ai * HALF + m * 16; const size_t off = (size_t)rr * 2048 + cl; float ss = 0.f;
#pragma unroll
                for (int bj = 0; bj < 2; ++bj) { const f32x4 x0 = *(const f32x4*)(x + off + bj * HALF), x1 = *(const f32x4*)(x + off + bj * HALF + 4);
                    const f32x4 h0 = x0 + acc[ai][bj][m][0], h1 = x1 + acc[ai][bj][m][1];
                    ss += (h0[0] * h0[0] + h0[1] * h0[1]) + (h0[2] * h0[2] + h0[3] * h0[3]) + (h1[0] * h1[0] + h1[1] * h1[1]) + (h1[2] * h1[2] + h1[3] * h1[3]);
                    u32x4 w; w.x = cvt_pk_bf16(h0[0], h0[1]); w.y = cvt_pk_bf16(h0[2], h0[3]); w.z = cvt_pk_bf16(h1[0], h1[1]); w.w = cvt_pk_bf16(h1[2], h1[3]);
                    *(u32x4*)(H1B + off + bj * HALF) = w; }
                ss += __shfl_xor(ss, 16); ss += __shfl_xor(ss, 32);
                if (fq == 0) SS1[(size_t)rr * 32 + u.pn * 4 + wc] = ss; }
    }
};
struct EpiGU {
    const float* SS1; bf16_t* HID; const LAS float* RS; int pm0;
    __device__ __forceinline__ void operator()(const AccT& acc, const Unit& u, int wr, int wc, int fr, int fq) const {
        const int row0 = u.pm * BM + wr * 64 + fr, cl = u.pn * 128 + wc * 32 + 8 * fq;
#pragma unroll
        for (int ai = 0; ai < 2; ++ai)
#pragma unroll
            for (int m = 0; m < 4; ++m) { const int rr = row0 + ai * HALF + m * 16; float rstd;
                if (u.pm == pm0) rstd = RS[ai * HALF + wr * 64 + m * 16 + fr];
                else { const f32x4* sp = (const f32x4*)(SS1 + (size_t)rr * 32) + 2 * fq; float ss;
                    { const f32x4 s0 = sp[0], s1 = sp[1]; ss = ((s0[0] + s0[1]) + (s0[2] + s0[3])) + ((s1[0] + s1[1]) + (s1[2] + s1[3])); }
                    ss += __shfl_xor(ss, 16); ss += __shfl_xor(ss, 32);
                    rstd = __builtin_amdgcn_rsqf(ss * (1.0f / 2048.0f) + RMS_EPS); }
                const f32x4 g0 = acc[ai][0][m][0] * rstd, g1 = acc[ai][0][m][1] * rstd, u0 = acc[ai][1][m][0] * rstd, u1 = acc[ai][1][m][1] * rstd;
                u32x4 w; w.x = cvt_pk_bf16(fast_silu(g0[0]) * u0[0], fast_silu(g0[1]) * u0[1]); w.y = cvt_pk_bf16(fast_silu(g0[2]) * u0[2], fast_silu(g0[3]) * u0[3]);
                w.z = cvt_pk_bf16(fast_silu(g1[0]) * u1[0], fast_silu(g1[1]) * u1[1]); w.w = cvt_pk_bf16(fast_silu(g1[2]) * u1[2], fast_silu(g1[3]) * u1[3]);
                *(u32x4*)(HID + (size_t)rr * FFN + cl) = w; }
    }
};
struct EpiDown {
    const bf16_t* H1B; bf16_t* H2B;
    __device__ __forceinline__ void operator()(const AccT& acc, const Unit& u, int wr, int wc, int fr, int fq) const {
        const int row0 = u.pm * BM + wr * 64 + fr, cl = u.pn * 256 + wc * 32 + 8 * fq;
#pragma unroll
        for (int ai = 0; ai < 2; ++ai)
#pragma unroll
            for (int m = 0; m < 4; ++m) { const size_t off = (size_t)(row0 + ai * HALF + m * 16) * 2048 + cl;
#pragma unroll
                for (int bj = 0; bj < 2; ++bj) { const u32x4 hw = *(const u32x4*)(H1B + off + bj * HALF); const f32x4 v0 = acc[ai][bj][m][0], v1 = acc[ai][bj][m][1];
                    u32x4 w; w.x = cvt_pk_bf16(bf_lo(hw.x) + v0[0], bf_hi(hw.x) + v0[1]); w.y = cvt_pk_bf16(bf_lo(hw.y) + v0[2], bf_hi(hw.y) + v0[3]);
                    w.z = cvt_pk_bf16(bf_lo(hw.z) + v1[0], bf_hi(hw.z) + v1[1]); w.w = cvt_pk_bf16(bf_lo(hw.w) + v1[2], bf_hi(hw.w) + v1[3]);
                    *(u32x4*)(H2B + off + bj * HALF) = w; } }
    }
};
}

constexpr int TR_LDS = 64 * 65 * 4;
struct TrDesc { const float* src; bf16_t* dst; const float* kscale; int ldw, ncols, ldk; };
struct TrRegs { f32x4 v[16]; float ks; };
__device__ __forceinline__ void tr_load(const TrDesc& d, TrRegs& R, int lane) {
    const int r4 = lane >> 4, cq = lane & 15;
    const bool on = 4 * cq < d.ncols;
    const float* sp = d.src + (size_t)r4 * d.ldw + (on ? 4 * cq : 0);
#pragma unroll
    for (int it = 0; it < 16; ++it) { const f32x4 x = *(const f32x4*)(sp + (size_t)(4 * it) * d.ldw); R.v[it] = on ? x : (f32x4){0.f, 0.f, 0.f, 0.f}; }
    R.ks = d.kscale ? d.kscale[lane] : 1.0f;
}
__device__ __forceinline__ void tr_finish(const TrDesc& d, const TrRegs& R, LAS float* scr, int lane, bool valid) {
    const int r4 = lane >> 4, cq = lane & 15;
#pragma unroll
    for (int it = 0; it < 16; ++it) { const int kk = 4 * it + r4; const float kv = __shfl(R.ks, kk); const f32x4 v = R.v[it] * kv;
        LAS float* q = scr + kk * 65 + 4 * cq; q[0] = v[0]; q[1] = v[1]; q[2] = v[2]; q[3] = v[3]; }
    LDS_WAIT(); asm volatile("" ::: "memory");
    const int cc = lane & 7;
#pragma unroll
    for (int j = 0; j < 8; ++j) { const int n = (lane >> 3) + 8 * j; const LAS float* sp = scr + (8 * cc) * 65 + n;
        u32x4 o; o.x = cvt_pk_bf16(sp[0 * 65], sp[1 * 65]); o.y = cvt_pk_bf16(sp[2 * 65], sp[3 * 65]); o.z = cvt_pk_bf16(sp[4 * 65], sp[5 * 65]); o.w = cvt_pk_bf16(sp[6 * 65], sp[7 * 65]);
        if (valid) *(u32x4*)(d.dst + (size_t)n * d.ldk + 8 * cc) = o; }
    LDS_WAIT(); asm volatile("" ::: "memory");
}
constexpr int EARLY_ITEMS = 148 * 32 + 32 * 16 + 32 * 16;
__device__ __forceinline__ TrDesc early_desc(const Params& p, int r) {
    unsigned char* ws = p.ws; TrDesc d; d.kscale = nullptr;
    constexpr int I_IN = 148 * 32, I_A = 32 * 16;
    if (r < I_IN) { const int rb = r / 32, kb = r % 32, dst = rb * 64; int src, nc;
        if (dst < 9216) { src = dst + (dst >= 4096 ? 16 : 0); nc = 64; } else if (dst == 9216) { src = 4096; nc = 16; } else { src = 0; nc = 0; }
        d.src = p.w_in + (size_t)(kb * 64) * 9232 + src; d.ldw = 9232; d.ncols = nc; d.dst = (bf16_t*)(ws + WS_WIN) + (size_t)dst * 2048 + kb * 64; d.ldk = 2048; return d; }
    r -= I_IN;
    const bool isb = r >= I_A; if (isb) r -= I_A;
    const int rb = r / 16, kb = r % 16;
    d.src = (isb ? p.w_proj_b : p.w_proj_a) + (size_t)(kb * 64) * 2048 + rb * 64; d.ldw = 2048; d.ncols = 64; d.dst = (bf16_t*)(ws + (isb ? WS_WB : WS_WA)) + (size_t)(rb * 64) * 1024 + kb * 64; d.ldk = 1024; return d;
}
constexpr int LATE_ITEMS = 32 * 32 + 2 * 88 * 32 + 32 * 88;
__device__ __forceinline__ TrDesc late_desc(const Params& p, int r) {
    unsigned char* ws = p.ws; TrDesc d; d.kscale = nullptr;
    constexpr int I_O = 32 * 32, I_G = 88 * 32;
    if (r < I_O) { const int rb = r / 32, kb = r % 32; d.src = p.w_out + (size_t)(kb * 64) * 2048 + rb * 64; d.ldw = 2048; d.ncols = 64; d.dst = (bf16_t*)(ws + WS_WOUT) + (size_t)(rb * 64) * 2048 + kb * 64; d.ldk = 2048; return d; }
    r -= I_O;
    if (r < 2 * I_G) { const bool up = r >= I_G; if (up) r -= I_G; const int rb = r / 32, kb = r % 32, j0 = rb * 64; const int dst = (j0 / 128) * 256 + (j0 % 128) + (up ? 128 : 0);
        d.src = (up ? p.w_up : p.w_gate) + (size_t)(kb * 64) * FFN + j0; d.ldw = FFN; d.ncols = 64; d.dst = (bf16_t*)(ws + WS_WGU) + (size_t)dst * 2048 + kb * 64; d.ldk = 2048; d.kscale = p.norm_ffn_w + kb * 64; return d; }
    r -= 2 * I_G;
    { const int rb = r / 88, kb = r % 88; d.src = p.w_down + (size_t)(kb * 64) * 2048 + rb * 64; d.ldw = 2048; d.ncols = 64; d.dst = (bf16_t*)(ws + WS_WD) + (size_t)(rb * 64) * FFN + kb * 64; d.ldk = FFN; return d; }
}
template <bool LATE>
__device__ __forceinline__ void convert_weights(const Params& p, LAS unsigned char* lds, int wv, int lane, int wg0, int nwg) {
    LAS float* scr = (LAS float*)(lds + wv * TR_LDS);
    const int gw = ((int)blockIdx.x - wg0) * 8 + wv, NGW = nwg * 8;
    constexpr int NI = LATE ? LATE_ITEMS : EARLY_ITEMS;
    const int trips = (NI + NGW - 1) / NGW;
#define TR_DESC(i_) (LATE ? late_desc(p, (i_) < NI ? (i_) : NI - 1) : early_desc(p, (i_) < NI ? (i_) : NI - 1))
    TrDesc d0 = TR_DESC(gw), d1 = TR_DESC(gw + NGW);
    TrRegs r0, r1;
    tr_load(d0, r0, lane); tr_load(d1, r1, lane);
    for (int k = 0; k < trips; k += 2) {
        const int i0 = gw + k * NGW, i1 = i0 + NGW;
        tr_finish(d0, r0, scr, lane, i0 < NI);
        d0 = TR_DESC(i0 + 2 * NGW); tr_load(d0, r0, lane);
        tr_finish(d1, r1, scr, lane, (k + 1 < trips) && i1 < NI);
        d1 = TR_DESC(i1 + 2 * NGW); tr_load(d1, r1, lane);
    }
#undef TR_DESC
}

__device__ __forceinline__ void phase0(const Params& p, LAS unsigned char* lds, int wv, int lane) {
    unsigned char* ws = p.ws;
    const int gw = blockIdx.x * 8 + wv, NGW = gridDim.x * 8;
    convert_weights<false>(p, lds, wv, lane, 0, (int)gridDim.x);
    { bf16_t* PB = (bf16_t*)(ws + WS_POOLT);
      for (int i = blockIdx.x * NTHREADS + threadIdx.x; i < 4 * 256 * 256 / 4; i += gridDim.x * NTHREADS) {
          const int e = 4 * i, g = e >> 16, d = e & 255; const f32x4 v = *(const f32x4*)(p.pool_w + e); const f32x4 sc = *(const f32x4*)(p.pool_scale + g * 256 + d);
          u32x2 o; o.x = cvt_pk_bf16(v[0] * sc[0], v[1] * sc[1]); o.y = cvt_pk_bf16(v[2] * sc[2], v[3] * sc[3]); *(u32x2*)(PB + e) = o; } }
    bf16_t* HN = (bf16_t*)(ws + WS_HN);
    for (int row = gw; row < RP; row += NGW) {
        const float* src = nullptr;
        if (row < RPV) { const int b = row / TB, pos = row - b * TB; if (pos >= 64) src = p.x + (size_t)(b * SEQ + pos - 64) * D; else if (pos >= 48) src = p.meta + (size_t)(pos - 48) * D; }
        u32x2* o8 = (u32x2*)(HN + (size_t)row * D) + lane;
        if (!src) {
#pragma unroll
            for (int j = 0; j < 8; ++j) o8[64 * j] = (u32x2){0u, 0u};
        } else {
            const f32x4* xr = (const f32x4*)src + lane; const f32x4* wr_ = (const f32x4*)p.norm_mix_w + lane;
            f32x4 v[8]; float s = 0.f;
#pragma unroll
            for (int j = 0; j < 8; ++j) { v[j] = xr[64 * j]; s += (v[j][0] * v[j][0] + v[j][1] * v[j][1]) + (v[j][2] * v[j][2] + v[j][3] * v[j][3]); }
            const float rstd = __builtin_amdgcn_rsqf(wave_sum(s) * (1.0f / D) + RMS_EPS);
#pragma unroll
            for (int j = 0; j < 8; ++j) { const f32x4 w = wr_[64 * j]; u32x2 o; o.x = cvt_pk_bf16(v[j][0] * rstd * w[0], v[j][1] * rstd * w[1]); o.y = cvt_pk_bf16(v[j][2] * rstd * w[2], v[j][3] * rstd * w[3]); o8[64 * j] = o; }
        }
    }
}

__device__ __forceinline__ void prep_phase(const Params& p, LAS unsigned char* lds, int wv, int lane_in) {
    unsigned char* ws = p.ws;
    LAS float* AM = (LAS float*)(lds);
    LAS bf16_t* TM = (LAS bf16_t*)(lds + 17408);
    LAS bf16_t* QN = (LAS bf16_t*)(lds + 26624);
    LAS bf16_t* KN = (LAS bf16_t*)(lds + 44032);
    LAS bf16_t* KBT = (LAS bf16_t*)(lds + 61440);
    LAS bf16_t* VBT = (LAS bf16_t*)(lds + 79872);
    const bf16_t* QKV = (const bf16_t*)(ws + WS_QKV); const float* BA = (const float*)(ws + WS_BA); float* GL = (float*)(ws + WS_GL);
    const float qscale = 0.08838834764831845f;
    for (int unit = blockIdx.x; unit < NUNIT; unit += gridDim.x) {
        const int b = unit / (NCH * NH), rem = unit % (NCH * NH), n = rem / NH, h = rem % NH;
        const int r0 = b * TB + n * 64;
        int lane = lane_in; asm volatile("" : "+v"(lane));
        const int fr = lane & 15, fq = lane >> 4;
        const int urec = (b * NH + h) * NCH + n;
        bf16_t* UA = (bf16_t*)p.out + (size_t)urec * 24576; bf16_t* UB = (bf16_t*)(ws + WS_PREPB) + (size_t)urec * 12288;
        bf16_t* uT = UA; bf16_t* wM = UA + 8192; bf16_t* qd = UA + 16384; bf16_t* kdT = UB; bf16_t* qkM = UB + 8192;
        float beta, gc, gcl;
        { const float bl = BA[(size_t)(r0 + lane) * 16 + h], al = BA[(size_t)(r0 + lane) * 16 + 8 + h];
          const bool valid = !(n == 0 && lane < 48);
          const float xg = al + p.dt_bias[h]; const float sp = fmaxf(xg, 0.f) + log1pf(expf(-fabsf(xg)));
          float g = valid ? -expf(p.a_log[h]) * sp : 0.f;
          beta = valid ? 1.0f / (1.0f + expf(-bl)) : 0.f;
#pragma unroll
          for (int o = 1; o < 64; o <<= 1) { const float t = __shfl_up(g, o); if (lane >= o) g += t; }
          gc = g; gcl = __shfl(gc, 63); }
        {
            const int t0 = wv * 8;
            unsigned xin[3][11]; float cw[3][4][2];
#pragma unroll
            for (int c3 = 0; c3 < 3; ++c3) {
#pragma unroll
                for (int i = 0; i < 11; ++i) { const int grow = r0 + t0 - 3 + i; xin[c3][i] = (grow >= 0) ? *(const unsigned*)(QKV + (size_t)grow * 3072 + c3 * 1024 + h * 128 + 2 * lane) : 0u; }
#pragma unroll
                for (int j = 0; j < 4; ++j) { const f32x2 w2 = *(const f32x2*)(p.conv_w + (size_t)j * 3072 + c3 * 1024 + h * 128 + 2 * lane); cw[c3][j][0] = w2[0]; cw[c3][j][1] = w2[1]; }
            }
            float kb[2][8], vb[2][8], kd[2][8];
            float y[8][3][2], ssq[8], ssk[8];
#pragma unroll
            for (int i = 0; i < 8; ++i) {
#pragma unroll
                for (int c3 = 0; c3 < 3; ++c3) { float a0 = 0.f, a1 = 0.f;
#pragma unroll
                    for (int j = 0; j < 4; ++j) { a0 += cw[c3][j][0] * bf_lo(xin[c3][i + j]); a1 += cw[c3][j][1] * bf_hi(xin[c3][i + j]); }
                    y[i][c3][0] = fast_silu(a0); y[i][c3][1] = fast_silu(a1); }
                ssq[i] = y[i][0][0] * y[i][0][0] + y[i][0][1] * y[i][0][1]; ssk[i] = y[i][1][0] * y[i][1][0] + y[i][1][1] * y[i][1][1];
            }
#pragma unroll
            for (int o = 1; o < 64; o <<= 1) {
#pragma unroll
                for (int i = 0; i < 8; ++i) { ssq[i] += __shfl_xor(ssq[i], o); ssk[i] += __shfl_xor(ssk[i], o); }
            }
#pragma unroll
            for (int i = 0; i < 8; ++i) {
                const int t = t0 + i;
                const float rq = __builtin_amdgcn_rsqf(ssq[i] + L2_EPS) * qscale, rk = __builtin_amdgcn_rsqf(ssk[i] + L2_EPS);
                const float bt = __shfl(beta, t), gct = __shfl(gc, t);
                const float eg = __expf(gct), egl = __expf(gcl - gct);
                const float q0 = y[i][0][0] * rq, q1 = y[i][0][1] * rq, k0 = y[i][1][0] * rk, k1 = y[i][1][1] * rk;
                *(LAS unsigned*)(QN + t * 136 + 2 * lane) = cvt_pk_bf16(q0, q1);
                *(LAS unsigned*)(KN + t * 136 + 2 * lane) = cvt_pk_bf16(k0, k1);
                *(unsigned*)(qd + ((((t >> 4) * 4 + (lane >> 4)) * 64 + ((lane & 15) >> 2) * 16 + (t & 15)) * 8 + 2 * (lane & 3))) = cvt_pk_bf16(q0 * eg, q1 * eg);
                kb[0][i] = k0 * bt * eg; kb[1][i] = k1 * bt * eg; vb[0][i] = y[i][2][0] * bt; vb[1][i] = y[i][2][1] * bt; kd[0][i] = k0 * egl; kd[1][i] = k1 * egl;
            }
#pragma unroll
            for (int ch = 0; ch < 2; ++ch) { const int d = 2 * lane + ch; u32x4 a, v, k;
                a.x = cvt_pk_bf16(kb[ch][0], kb[ch][1]); a.y = cvt_pk_bf16(kb[ch][2], kb[ch][3]); a.z = cvt_pk_bf16(kb[ch][4], kb[ch][5]); a.w = cvt_pk_bf16(kb[ch][6], kb[ch][7]);
                v.x = cvt_pk_bf16(vb[ch][0], vb[ch][1]); v.y = cvt_pk_bf16(vb[ch][2], vb[ch][3]); v.z = cvt_pk_bf16(vb[ch][4], vb[ch][5]); v.w = cvt_pk_bf16(vb[ch][6], vb[ch][7]);
                k.x = cvt_pk_bf16(kd[ch][0], kd[ch][1]); k.y = cvt_pk_bf16(kd[ch][2], kd[ch][3]); k.z = cvt_pk_bf16(kd[ch][4], kd[ch][5]); k.w = cvt_pk_bf16(kd[ch][6], kd[ch][7]);
                *(LAS u32x4*)(KBT + d * 72 + t0) = a; *(LAS u32x4*)(VBT + d * 72 + t0) = v;
                *(u32x4*)(kdT + ((((d >> 4) * 2 + (wv >> 2)) * 64 + (wv & 3) * 16 + (d & 15)) * 8)) = k; }
        }
        __syncthreads();
        {
            const int it = wv >> 1;
#pragma unroll
            for (int jj = 0; jj < 2; ++jj) { const int jt = (wv & 1) * 2 + jj;
                f32x4 akk = (f32x4){0.f, 0.f, 0.f, 0.f}, aqk = (f32x4){0.f, 0.f, 0.f, 0.f};
#pragma unroll
                for (int kk = 0; kk < 4; ++kk) {
                    const bf16x8 kni = *(const LAS bf16x8*)(KN + (it * 16 + fr) * 136 + kk * 32 + fq * 8);
                    const bf16x8 knj = *(const LAS bf16x8*)(KN + (jt * 16 + fr) * 136 + kk * 32 + fq * 8);
                    const bf16x8 qni = *(const LAS bf16x8*)(QN + (it * 16 + fr) * 136 + kk * 32 + fq * 8);
                    akk = __builtin_amdgcn_mfma_f32_16x16x32_bf16(kni, knj, akk, 0, 0, 0);
                    aqk = __builtin_amdgcn_mfma_f32_16x16x32_bf16(knj, qni, aqk, 0, 0, 0);
                }
                { const int j = jt * 16 + fr; const float gj = __shfl(gc, j);
#pragma unroll
                  for (int r = 0; r < 4; ++r) { const int i = it * 16 + fq * 4 + r; const float gi = __shfl(gc, i), bi = __shfl(beta, i);
                      AM[i * 68 + j] = (j < i) ? bi * akk[r] * expf(gi - gj) : 0.f; } }
                { const int i = it * 16 + fr; const float gi = __shfl(gc, i); float v[4];
#pragma unroll
                  for (int r = 0; r < 4; ++r) { const int j = jt * 16 + fq * 4 + r; const float gj = __shfl(gc, j); v[r] = (j <= i) ? aqk[r] * expf(gi - gj) : 0.f; }
                  u32x2 w; w.x = cvt_pk_bf16(v[0], v[1]); w.y = cvt_pk_bf16(v[2], v[3]);
                  *(u32x2*)(qkM + (((it * 2 + (jt >> 1)) * 64 + ((jt & 1) * 2 + (fq >> 1)) * 16 + fr) * 8 + (fq & 1) * 4)) = w; }
            }
        }
        __syncthreads();
        {
            LAS bf16_t* T11T = (LAS bf16_t*)(lds + 98304);
            LAS bf16_t* A21B = (LAS bf16_t*)(lds + 100864);
            LAS bf16_t* XT = (LAS bf16_t*)(lds + 103424);
            if (wv < 2) {
                const int o = wv * 32, c = lane & 31;
                float t[32];
#pragma unroll
                for (int i = 0; i < 32; ++i) {
                    float a0 = (c == i) ? 1.f : 0.f, a1 = 0.f, a2 = 0.f, a3 = 0.f;
#pragma unroll
                    for (int j = 0; j < (i & ~3); j += 4) { const f32x4 av = *(const LAS f32x4*)(AM + (o + i) * 68 + o + j); a0 -= av[0] * t[j]; a1 -= av[1] * t[j + 1]; a2 -= av[2] * t[j + 2]; a3 -= av[3] * t[j + 3]; }
#pragma unroll
                    for (int j = (i & ~3); j < i; ++j) a0 -= AM[(o + i) * 68 + o + j] * t[j];
                    t[i] = (a0 + a1) + (a2 + a3);
                    if (lane < 32) TM[(o + i) * 72 + o + c] = (bf16_t)(cvt_pk_bf16(t[i], 0.f) & 0xffffu);
                    else if (wv == 0) TM[i * 72 + lane] = (bf16_t)0;
                    asm volatile("" ::: "memory");
                }
                if (wv == 0 && lane < 32) {
#pragma unroll
                    for (int q = 0; q < 4; ++q) { u32x4 w; w.x = cvt_pk_bf16(t[8 * q], t[8 * q + 1]); w.y = cvt_pk_bf16(t[8 * q + 2], t[8 * q + 3]); w.z = cvt_pk_bf16(t[8 * q + 4], t[8 * q + 5]); w.w = cvt_pk_bf16(t[8 * q + 6], t[8 * q + 7]);
                        *(LAS u32x4*)(T11T + c * 40 + 8 * q) = w; }
                }
                if (wv == 0 && lane == 0) GL[urec] = expf(gcl);
            } else if (wv < 6) {
                const int e = (wv - 2) * 256 + lane * 4, i = e >> 5, k = e & 31;
                const f32x4 v = *(const LAS f32x4*)(AM + (32 + i) * 68 + k);
                u32x2 w; w.x = cvt_pk_bf16(v[0], v[1]); w.y = cvt_pk_bf16(v[2], v[3]);
                *(LAS u32x2*)(A21B + i * 40 + k) = w;
            }
            __syncthreads();
            const int it2 = (wv >> 1) & 1, jt2 = wv & 1;
            if (wv < 4) {
                const bf16x8 xa = *(const LAS bf16x8*)(A21B + (it2 * 16 + fr) * 40 + fq * 8);
                const bf16x8 yb = *(const LAS bf16x8*)(T11T + (jt2 * 16 + fr) * 40 + fq * 8);
                const f32x4 x = __builtin_amdgcn_mfma_f32_16x16x32_bf16(xa, yb, (f32x4){0.f, 0.f, 0.f, 0.f}, 0, 0, 0);
                u32x2 w; w.x = cvt_pk_bf16(x[0], x[1]); w.y = cvt_pk_bf16(x[2], x[3]);
                *(LAS u32x2*)(XT + (jt2 * 16 + fr) * 40 + it2 * 16 + fq * 4) = w;
            }
            __syncthreads();
            if (wv < 4) {
                const bf16x8 ta = *(const LAS bf16x8*)(TM + (32 + it2 * 16 + fr) * 72 + 32 + fq * 8);
                const bf16x8 xb = *(const LAS bf16x8*)(XT + (jt2 * 16 + fr) * 40 + fq * 8);
                const f32x4 r = __builtin_amdgcn_mfma_f32_16x16x32_bf16(ta, xb, (f32x4){0.f, 0.f, 0.f, 0.f}, 0, 0, 0);
#pragma unroll
                for (int q = 0; q < 4; ++q) TM[(32 + it2 * 16 + fq * 4 + q) * 72 + jt2 * 16 + fr] = (bf16_t)(cvt_pk_bf16(-r[q], 0.f) & 0xffffu);
            }
        }
        __syncthreads();
        {
#pragma unroll
            for (int ct = 0; ct < 4; ++ct) {
                f32x4 au = (f32x4){0.f, 0.f, 0.f, 0.f}, aw = (f32x4){0.f, 0.f, 0.f, 0.f};
#pragma unroll
                for (int kk = 0; kk < 2; ++kk) {
                    const bf16x8 tf = *(const LAS bf16x8*)(TM + (ct * 16 + fr) * 72 + kk * 32 + fq * 8);
                    const bf16x8 vf = *(const LAS bf16x8*)(VBT + (wv * 16 + fr) * 72 + kk * 32 + fq * 8);
                    const bf16x8 kf = *(const LAS bf16x8*)(KBT + (wv * 16 + fr) * 72 + kk * 32 + fq * 8);
                    au = __builtin_amdgcn_mfma_f32_16x16x32_bf16(tf, vf, au, 0, 0, 0);
                    aw = __builtin_amdgcn_mfma_f32_16x16x32_bf16(kf, tf, aw, 0, 0, 0);
                }
                u32x2 w1; w1.x = cvt_pk_bf16(au[0], au[1]); w1.y = cvt_pk_bf16(au[2], au[3]);
                *(u32x2*)(uT + ((wv * 4 + ct) * 64 + lane) * 4) = w1;
                u32x2 w2; w2.x = cvt_pk_bf16(aw[0], aw[1]); w2.y = cvt_pk_bf16(aw[2], aw[3]);
                *(u32x2*)(wM + (((ct * 4 + (wv >> 1)) * 64 + ((wv & 1) * 2 + (fq >> 1)) * 16 + fr) * 8 + (fq & 1) * 4)) = w2;
            }
        }
        __syncthreads();
    }
}

struct ScanRegs { bf16x8 X[4]; bf16x8 Y[2]; bf16x8 KD[2]; u32x2 UU; float gl; };
__device__ __forceinline__ void scan_load(ScanRegs& R, const bf16_t* baseA, const bf16_t* baseB, const float* GL, int unit, int es, int ct, bool roleB, int dt, int lane) {
    const bf16_t* xb = baseA + (roleB ? 16384 : 8192);
#pragma unroll
    for (int kk = 0; kk < 4; ++kk) R.X[kk] = *(const bf16x8*)(xb + ((ct * 4 + kk) * 64 + lane) * 8);
#pragma unroll
    for (int kk = 0; kk < 2; ++kk) R.KD[kk] = *(const bf16x8*)(baseB + ((dt * 2 + kk) * 64 + lane) * 8);
#pragma unroll
    for (int kk = 0; kk < 2; ++kk) R.Y[kk] = *(const bf16x8*)(baseB + 8192 + (roleB ? ((ct * 2 + kk) * 64 + lane) * 8 : 0));
    R.UU = *(const u32x2*)(baseA + (roleB ? 0 : ((es * 4 + ct) * 64 + lane) * 4));
    R.gl = GL[unit];
}
#define LDS_BARRIER() do { asm volatile("s_waitcnt lgkmcnt(0)" ::: "memory"); __builtin_amdgcn_s_barrier(); asm volatile("" ::: "memory"); } while (0)
__device__ __forceinline__ void scan_step(const ScanRegs& cur, f32x4& sacc, LAS bf16_t* SBc, LAS bf16_t* SBn, LAS bf16_t* VN, bf16_t* Orow  , int ct, bool roleB, int dt, int fr, int fq, int hcol) {
    bf16x8 sbf[4];
#pragma unroll
    for (int kk = 0; kk < 4; ++kk) sbf[kk] = *(const LAS bf16x8*)(SBc + fr * 136 + kk * 32 + fq * 8);
    f32x4 a = (f32x4){0.f, 0.f, 0.f, 0.f};
    if (!roleB) {
#pragma unroll
        for (int kk = 0; kk < 4; ++kk) a = __builtin_amdgcn_mfma_f32_16x16x32_bf16(cur.X[kk], sbf[kk], a, 0, 0, 0);
        const float v0 = bf_lo(cur.UU.x) - a[0], v1 = bf_hi(cur.UU.x) - a[1], v2 = bf_lo(cur.UU.y) - a[2], v3 = bf_hi(cur.UU.y) - a[3];
        u32x2 w; w.x = cvt_pk_bf16(v0, v1); w.y = cvt_pk_bf16(v2, v3);
        *(LAS u32x2*)(VN + fr * 72 + ct * 16 + fq * 4) = w;
    } else {
#pragma unroll
        for (int kk = 0; kk < 4; ++kk) a = __builtin_amdgcn_mfma_f32_16x16x32_bf16(sbf[kk], cur.X[kk], a, 0, 0, 0);
    }
    LDS_BARRIER();
    bf16x8 vnf[2];
#pragma unroll
    for (int kk = 0; kk < 2; ++kk) vnf[kk] = *(const LAS bf16x8*)(VN + fr * 72 + kk * 32 + fq * 8);
    sacc = sacc * cur.gl;
#pragma unroll
    for (int kk = 0; kk < 2; ++kk) sacc = __builtin_amdgcn_mfma_f32_16x16x32_bf16(cur.KD[kk], vnf[kk], sacc, 0, 0, 0);
    { u32x2 w; w.x = cvt_pk_bf16(sacc[0], sacc[1]); w.y = cvt_pk_bf16(sacc[2], sacc[3]);
      *(LAS u32x2*)(SBn + fr * 136 + dt * 16 + fq * 4) = w; }
    if (roleB) {
#pragma unroll
        for (int kk = 0; kk < 2; ++kk) a = __builtin_amdgcn_mfma_f32_16x16x32_bf16(vnf[kk], cur.Y[kk], a, 0, 0, 0);
        u32x2 w; w.x = cvt_pk_bf16(a[0], a[1]); w.y = cvt_pk_bf16(a[2], a[3]);
        *(u32x2*)(Orow + (size_t)(ct * 16 + fr) * 1024 + hcol + fq * 4) = w;
    }
    LDS_BARRIER();
}
__device__ __forceinline__ void scan_phase(const Params& p, LAS unsigned char* lds, int wv, int lane) {
    if (blockIdx.x >= 128) return;
    unsigned char* ws = p.ws;
    const int tid = threadIdx.x, fr = lane & 15, fq = lane >> 4;
    const int xcd_ = blockIdx.x & 7, j_ = blockIdx.x >> 3, bh_ = xcd_ * 2 + (j_ >> 3);
    const int b = bh_ >> 3, h = bh_ & 7, es = j_ & 7, e0 = es * 16;
    const int ct = wv & 3, dt = wv; const bool roleB = wv >= 4;
    LAS bf16_t* SB = (LAS bf16_t*)lds;
    LAS bf16_t* VN = (LAS bf16_t*)(lds + 8704);
    const bf16_t* PREPA = (const bf16_t*)p.out; const bf16_t* PREPB = (const bf16_t*)(ws + WS_PREPB); const float* GL = (const float*)(ws + WS_GL); bf16_t* O = (bf16_t*)(ws + WS_O);
    for (int i = tid; i < 2 * 16 * 136 / 2; i += NTHREADS) ((LAS unsigned*)SB)[i] = 0u;
    __syncthreads();
    f32x4 sacc = (f32x4){0.f, 0.f, 0.f, 0.f};
    const int ubase = (b * NH + h) * NCH;
    const int hcol = h * 128 + e0;
    bf16_t* Ob = O + (size_t)(b * TB) * 1024;
#define SCAN_LOAD(R, n_) do { const int nn_ = (n_) < NCH ? (n_) : NCH - 1; const int unit_ = ubase + nn_; scan_load(R, PREPA + (size_t)unit_ * 24576, PREPB + (size_t)unit_ * 12288, GL, unit_, es, ct, roleB, dt, lane); } while (0)
#define SCAN_STEP(R, n_, SBr, SBw) scan_step(R, sacc, SBr, SBw, VN, Ob + (size_t)((n_) * 64) * 1024, ct, roleB, dt, fr, fq, hcol)
    ScanRegs r0, r1, r2, r3, r4;
    SCAN_LOAD(r0, 0); SCAN_LOAD(r1, 1); SCAN_LOAD(r2, 2); SCAN_LOAD(r3, 3);
    LAS bf16_t* SB0 = SB; LAS bf16_t* SB1 = SB + 2176;
    for (int n = 0; n < NCH; n += 5) {
        const bool odd = ((n / 5) & 1) != 0;
        LAS bf16_t* A0 = odd ? SB1 : SB0; LAS bf16_t* A1 = odd ? SB0 : SB1;
        SCAN_LOAD(r4, n + 4); SCAN_STEP(r0, n, A0, A1);
        SCAN_LOAD(r0, n + 5); if (n + 1 < NCH) SCAN_STEP(r1, n + 1, A1, A0);
        SCAN_LOAD(r1, n + 6); if (n + 2 < NCH) SCAN_STEP(r2, n + 2, A0, A1);
        SCAN_LOAD(r2, n + 7); if (n + 3 < NCH) SCAN_STEP(r3, n + 3, A1, A0);
        SCAN_LOAD(r3, n + 8); if (n + 4 < NCH) SCAN_STEP(r4, n + 4, A0, A1);
    }
#undef SCAN_LOAD
#undef SCAN_STEP
    asm volatile("s_waitcnt vmcnt(0)" ::: "memory");
    __syncthreads();
}

__device__ __forceinline__ void phase4(const Params& p, LAS unsigned char* lds, int wv, int lane) {
    unsigned char* ws = p.ws;
    const int gw = blockIdx.x * 8 + wv, NGW = gridDim.x * 8;
    { const bf16_t* O = (const bf16_t*)(ws + WS_O); const bf16_t* Z = (const bf16_t*)(ws + WS_Z); bf16_t* OG = (bf16_t*)(ws + WS_OG);
      f32x4 nw[4];
#pragma unroll
      for (int i = 0; i < 4; ++i) nw[i] = *(const f32x4*)(p.o_norm_w + (lane & 7) * 16 + 4 * i);
      for (int rr = gw; rr < RR; rr += NGW) {
          const int prow = rr + 64 + ((rr >> 13) << 6);
          const u32x4 o0 = *(const u32x4*)(O + (size_t)prow * 1024 + lane * 16), o1 = *(const u32x4*)(O + (size_t)prow * 1024 + lane * 16 + 8);
          const u32x4 z0 = *(const u32x4*)(Z + (size_t)prow * 1024 + lane * 16), z1 = *(const u32x4*)(Z + (size_t)prow * 1024 + lane * 16 + 8);
          float ov[16], zv[16];
          ov[0] = bf_lo(o0.x); ov[1] = bf_hi(o0.x); ov[2] = bf_lo(o0.y); ov[3] = bf_hi(o0.y); ov[4] = bf_lo(o0.z); ov[5] = bf_hi(o0.z); ov[6] = bf_lo(o0.w); ov[7] = bf_hi(o0.w);
          ov[8] = bf_lo(o1.x); ov[9] = bf_hi(o1.x); ov[10] = bf_lo(o1.y); ov[11] = bf_hi(o1.y); ov[12] = bf_lo(o1.z); ov[13] = bf_hi(o1.z); ov[14] = bf_lo(o1.w); ov[15] = bf_hi(o1.w);
          zv[0] = bf_lo(z0.x); zv[1] = bf_hi(z0.x); zv[2] = bf_lo(z0.y); zv[3] = bf_hi(z0.y); zv[4] = bf_lo(z0.z); zv[5] = bf_hi(z0.z); zv[6] = bf_lo(z0.w); zv[7] = bf_hi(z0.w);
          zv[8] = bf_lo(z1.x); zv[9] = bf_hi(z1.x); zv[10] = bf_lo(z1.y); zv[11] = bf_hi(z1.y); zv[12] = bf_lo(z1.z); zv[13] = bf_hi(z1.z); zv[14] = bf_lo(z1.w); zv[15] = bf_hi(z1.w);
          float ss = 0.f;
#pragma unroll
          for (int i = 0; i < 16; ++i) ss += ov[i] * ov[i];
          ss += __shfl_xor(ss, 1); ss += __shfl_xor(ss, 2); ss += __shfl_xor(ss, 4);
          const float rstd = __builtin_amdgcn_rsqf(ss * (1.0f / 128.0f) + RMS_EPS);
          float r[16];
#pragma unroll
          for (int i = 0; i < 16; ++i) r[i] = ov[i] * rstd * nw[i >> 2][i & 3] * zv[i];
          u32x4 w0, w1; w0.x = cvt_pk_bf16(r[0], r[1]); w0.y = cvt_pk_bf16(r[2], r[3]); w0.z = cvt_pk_bf16(r[4], r[5]); w0.w = cvt_pk_bf16(r[6], r[7]);
          w1.x = cvt_pk_bf16(r[8], r[9]); w1.y = cvt_pk_bf16(r[10], r[11]); w1.z = cvt_pk_bf16(r[12], r[13]); w1.w = cvt_pk_bf16(r[14], r[15]);
          *(u32x4*)(OG + (size_t)rr * 1024 + lane * 16) = w0; *(u32x4*)(OG + (size_t)rr * 1024 + lane * 16 + 8) = w1;
      } }
    { const bf16_t* P = (const bf16_t*)(ws + WS_P); bf16_t* PO = (bf16_t*)(ws + WS_POOLED);
      const int gt = blockIdx.x * NTHREADS + threadIdx.x, NT = gridDim.x * NTHREADS;
      for (int idx = gt; idx < 4 * RR * 32; idx += NT) {
          const int cbl = idx & 31, rr = (idx >> 5) & (RR - 1), g = idx >> 19;
          const int win = 2 << g; const int prow = rr + 64 + ((rr >> 13) << 6); const int col = g * 256 + cbl * 8;
          float acc[8], self[8];
#pragma unroll
          for (int i = 0; i < 8; ++i) acc[i] = 0.f;
          for (int s = 0; s < win; ++s) { const u32x4 v = *(const u32x4*)(P + (size_t)(prow - s) * 1024 + col);
              const float f0 = bf_lo(v.x), f1 = bf_hi(v.x), f2 = bf_lo(v.y), f3 = bf_hi(v.y), f4 = bf_lo(v.z), f5 = bf_hi(v.z), f6 = bf_lo(v.w), f7 = bf_hi(v.w);
              if (s == 0) { self[0] = f0; self[1] = f1; self[2] = f2; self[3] = f3; self[4] = f4; self[5] = f5; self[6] = f6; self[7] = f7; }
              acc[0] += f0; acc[1] += f1; acc[2] += f2; acc[3] += f3; acc[4] += f4; acc[5] += f5; acc[6] += f6; acc[7] += f7; }
          const float inv = 1.0f / (float)win;
          u32x4 w; w.x = cvt_pk_bf16(acc[0] * inv - self[0], acc[1] * inv - self[1]); w.y = cvt_pk_bf16(acc[2] * inv - self[2], acc[3] * inv - self[3]);
          w.z = cvt_pk_bf16(acc[4] * inv - self[4], acc[5] * inv - self[5]); w.w = cvt_pk_bf16(acc[6] * inv - self[6], acc[7] * inv - self[7]);
          *(u32x4*)(PO + (size_t)rr * 1024 + col) = w;
      } }
}

__device__ __forceinline__ void final_phase(const Params& p, int wv, int lane) {
    const int gw = blockIdx.x * 8 + wv, NGW = gridDim.x * 8;
    const bf16_t* H2B = (const bf16_t*)(p.ws + WS_H2B);
    for (int rr = gw; rr < RR; rr += NGW) {
        const u32x4* hr = (const u32x4*)(H2B + (size_t)rr * D) + lane;
        u32x4 h[4]; float s = 0.f;
#pragma unroll
        for (int j = 0; j < 4; ++j) { h[j] = hr[64 * j];
            const float f0 = bf_lo(h[j].x), f1 = bf_hi(h[j].x), f2 = bf_lo(h[j].y), f3 = bf_hi(h[j].y), f4 = bf_lo(h[j].z), f5 = bf_hi(h[j].z), f6 = bf_lo(h[j].w), f7 = bf_hi(h[j].w);
            s += ((f0 * f0 + f1 * f1) + (f2 * f2 + f3 * f3)) + ((f4 * f4 + f5 * f5) + (f6 * f6 + f7 * f7)); }
        const float rstd = __builtin_amdgcn_rsqf(wave_sum(s) * (1.0f / D) + RMS_EPS);
#pragma unroll
        for (int j = 0; j < 4; ++j) { const int e = 8 * (lane + 64 * j); const f32x4 w0 = *(const f32x4*)(p.norm_final_w + e), w1 = *(const f32x4*)(p.norm_final_w + e + 4);
            f32x4 o0, o1; o0[0] = bf_lo(h[j].x) * rstd * w0[0]; o0[1] = bf_hi(h[j].x) * rstd * w0[1]; o0[2] = bf_lo(h[j].y) * rstd * w0[2]; o0[3] = bf_hi(h[j].y) * rstd * w0[3];
            o1[0] = bf_lo(h[j].z) * rstd * w1[0]; o1[1] = bf_hi(h[j].z) * rstd * w1[1]; o1[2] = bf_lo(h[j].w) * rstd * w1[2]; o1[3] = bf_hi(h[j].w) * rstd * w1[3];
            *(f32x4*)(p.out + (size_t)rr * D + e) = o0; *(f32x4*)(p.out + (size_t)rr * D + e + 4) = o1; }
    }
}

#define XB_TMO      128
#define XB_XCNT(j)  (256  + 64 * (j))
#define XB_XSUB(j)  (1280 + 64 * (j))
#define XB_XGEN(j)  (2304 + 64 * (j))
#define XB_TOP      3328
#define XB_TOPGEN   3392
#define XCD_BAR_WORDS 3456
#define XB_SPIN_CAP (1u << 22)
__device__ __forceinline__ unsigned xb_ld(unsigned* p)              { return __hip_atomic_load(p, __ATOMIC_RELAXED, __HIP_MEMORY_SCOPE_AGENT); }
__device__ __forceinline__ unsigned xb_add(unsigned* p, unsigned v) { return __hip_atomic_fetch_add(p, v, __ATOMIC_RELAXED, __HIP_MEMORY_SCOPE_AGENT); }
__device__ __forceinline__ unsigned xb_xcc_id() { return (unsigned)__builtin_amdgcn_s_getreg((3 << 11) | 20) & 0xFu; }
#define XB_SPIN(cond, bar) do { unsigned _sp = 0; while (cond) { __builtin_amdgcn_s_sleep(1); \
    if ((++_sp & 255u) == 0u) { if (xb_ld(&(bar)[XB_TMO])) break; if (_sp > XB_SPIN_CAP) { atomicAdd(&(bar)[XB_TMO], 1u); break; } } } } while (0)
struct XcdBarrier { unsigned* bar; unsigned x; volatile LAS unsigned* st; };
__device__ __forceinline__ XcdBarrier xcd_barrier_post(unsigned* bar, volatile LAS unsigned* st) {
    XcdBarrier b; b.bar = bar; b.x = xb_xcc_id(); b.st = st;
    if (threadIdx.x == 0) (void)xb_add(&bar[XB_XCNT(b.x)], 1u);
    return b;
}
__device__ __forceinline__ void xcd_barrier_complete(unsigned* bar, unsigned x, unsigned& nloc, unsigned& nx) {
    const unsigned G = gridDim.x * gridDim.y * gridDim.z;
    unsigned sum, cnt, mine, sp = 0u;
    for (;;) {
        sum = 0u; cnt = 0u; mine = 0u;
#pragma unroll
        for (unsigned j = 0; j < 16; ++j) { const unsigned c = xb_ld(&bar[XB_XCNT(j)]); sum += c; cnt += (c > 0u) ? 1u : 0u; mine = (j == x) ? c : mine; }
        if (sum == G) break;
        __builtin_amdgcn_s_sleep(1);
        if ((++sp & 255u) == 0u) { if (xb_ld(&bar[XB_TMO])) break; if (sp > XB_SPIN_CAP) { atomicAdd(&bar[XB_TMO], 1u); break; } }
    }
    nloc = mine > 0u ? mine : 1u; nx = cnt > 0u ? cnt : 1u;
}
__device__ __forceinline__ void xcd_barrier(const XcdBarrier& b) {
    asm volatile("s_waitcnt vmcnt(0)" ::: "memory");
    __syncthreads();
    if (threadIdx.x == 0) {
        unsigned* bar = b.bar;
        __builtin_amdgcn_s_waitcnt(0);
        unsigned nloc = b.st[0], nx = b.st[1];
        if (nloc == 0u) { xcd_barrier_complete(bar, b.x, nloc, nx); b.st[0] = nloc; b.st[1] = nx; }
        const unsigned old = xb_add(&bar[XB_XSUB(b.x)], 1u);
        const unsigned gen = old / nloc;
        if (old + 1u == (gen + 1u) * nloc) {
            __builtin_amdgcn_fence(__ATOMIC_RELEASE, "agent");
            asm volatile("s_waitcnt vmcnt(0)" ::: "memory");
            const unsigned og = xb_add(&bar[XB_TOP], 1u);
            const unsigned tg = og / nx;
            if (og + 1u == (tg + 1u) * nx) xb_add(&bar[XB_TOPGEN], 1u);
            else XB_SPIN(xb_ld(&bar[XB_TOPGEN]) == tg, bar);
            __builtin_amdgcn_fence(__ATOMIC_ACQUIRE, "agent");
            xb_add(&bar[XB_XGEN(b.x)], 1u);
            asm volatile("s_waitcnt vmcnt(0)" ::: "memory");
        } else {
            XB_SPIN(xb_ld(&bar[XB_XGEN(b.x)]) == gen, bar);
            __builtin_amdgcn_fence(__ATOMIC_ACQUIRE, "agent");
            asm volatile("s_waitcnt vmcnt(0)" ::: "memory");
        }
    }
    __syncthreads();
}

__global__ void __launch_bounds__(NTHREADS, 2) fwd_kernel(Params p) {
    extern __shared__ __attribute__((aligned(16))) unsigned char lds_raw[];
    LAS unsigned char* lds = (LAS unsigned char*)lds_raw;
    const int tid = threadIdx.x, wv = __builtin_amdgcn_readfirstlane(tid >> 6), lane = tid & 63;
    unsigned char* ws = p.ws;
    const int lo = (int)p.phase_lo, hi = (int)p.phase_hi;
#ifndef PH_MASK
#define PH_MASK 0x7ff
#endif
#define IN(k) (((PH_MASK >> (k)) & 1) && lo <= (k) && (k) < hi)
#if MK_MULTI
#define SYNC(k) do { } while (0)
#else
    cg::grid_group grid = cg::this_grid();
    volatile LAS unsigned* MISC = (volatile LAS unsigned*)(lds + LDS_BYTES - 256);
    if (tid < 32) MISC[tid] = 0u;
    __syncthreads();
    const XcdBarrier xbar = xcd_barrier_post((unsigned*)ws, MISC + 8);
#define SYNC(k) do { xcd_barrier(xbar); } while (0)
    if (hi > 1000) grid.sync();
#endif
#ifndef REP_MASK
#define REP_MASK 0
#endif
#define NREP(k) (((REP_MASK >> (k)) & 1) ? 2 : 1)
    const int G = gridDim.x, c = blockIdx.x;
    if (IN(0)) for (int rep = 0; rep < NREP(0); ++rep) { phase0(p, lds, wv, lane); SYNC(0); }
    if (IN(1)) for (int rep = 0; rep < NREP(1); ++rep) {
        pg8::Gemm g{(const bf16_t*)(ws + WS_HN), (const bf16_t*)(ws + WS_WIN), 2048, 2048, 2048, 0}; pg8::StaticOrder S; S.init(RP, NIN, G, c);
        pg8::EpiIn E{(bf16_t*)(ws + WS_QKV), (bf16_t*)(ws + WS_Z), (bf16_t*)(ws + WS_P), (unsigned char*)(ws + WS_GAB), (float*)(ws + WS_BA)};
        pg8::gemm_phase(lds, g, S, E);
        const int wc_ = (G == 256) ? ((c >= (65 * 37) % 256 && c < (65 * 37) % 256 + 32) ? c - (65 * 37) % 256 : -1) : c;
        if (wc_ >= 0) {
            pg8::Gemm g2{(const bf16_t*)(ws + WS_WB), (const bf16_t*)(ws + WS_POOLT), 1024, 256, 256, 256}; pg8::StaticOrder S; S.init(2048, 1024, G, wc_);
            pg8::EpiPlain E2{(bf16_t*)(ws + WS_WEFF), 1024};
            pg8::gemm_phase(lds, g2, S, E2); }
        { constexpr int NFULL = (65 * 37) % 256; if (G == 256 && c >= NFULL) convert_weights<true>(p, lds, wv, lane, NFULL, 256 - NFULL); else if (G != 256) convert_weights<true>(p, lds, wv, lane, 0, G); }
        SYNC(1); }
    if (IN(2)) for (int rep = 0; rep < NREP(2); ++rep) { prep_phase(p, lds, wv, lane); SYNC(2); }
    if (IN(3)) for (int rep = 0; rep < NREP(3); ++rep) { scan_phase(p, lds, wv, lane); SYNC(3); }
    if (IN(4)) for (int rep = 0; rep < NREP(4); ++rep) { phase4(p, lds, wv, lane); SYNC(4); }
    if (IN(6)) for (int rep = 0; rep < NREP(6); ++rep) {
        pg8::StaticOrder S; S.init(RR, 2048, G, c);
        { pg8::Gemm g{(const bf16_t*)(ws + WS_OG), (const bf16_t*)(ws + WS_WA), 1024, 1024, 1024, 0};
          pg8::EpiMerge<false> E{(const unsigned char*)(ws + WS_GAB), (bf16_t*)(ws + WS_MERGED)}; pg8::gemm_phase(lds, g, S, E); }
        { pg8::Gemm g{(const bf16_t*)(ws + WS_POOLED), (const bf16_t*)(ws + WS_WEFF), 1024, 1024, 1024, 0};
          pg8::EpiMerge<true> E{(const unsigned char*)(ws + WS_GAB), (bf16_t*)(ws + WS_MERGED)}; pg8::gemm_phase(lds, g, S, E); }
        SYNC(6); }
    if (IN(7)) for (int rep = 0; rep < NREP(7); ++rep) {
        pg8::Gemm g{(const bf16_t*)(ws + WS_MERGED), (const bf16_t*)(ws + WS_WOUT), 2048, 2048, 2048, 0}; pg8::StaticOrder S; S.init(RR, 2048, G, c);
        pg8::EpiOut E{p.x, (bf16_t*)(ws + WS_H1B), (float*)(ws + WS_SS1)};
        pg8::gemm_phase(lds, g, S, E); SYNC(7); }
    if (IN(8)) for (int rep = 0; rep < NREP(8); ++rep) {
        pg8::Gemm g{(const bf16_t*)(ws + WS_H1B), (const bf16_t*)(ws + WS_WGU), 2048, 2048, 2048, 0}; pg8::StaticOrder S; S.init(RR, 2 * FFN, G, c);
        pg8::Unit u0; const bool has0 = S.next(0, u0); const int pm0 = has0 ? u0.pm : -1;
        LAS float* RS = (LAS float*)(lds + 135168);
        if (has0 && tid < 256) { const f32x4* sp = (const f32x4*)((const float*)(ws + WS_SS1) + (size_t)(pm0 * 256 + tid) * 32); float ss = 0.f;
#pragma unroll
            for (int i = 0; i < 8; ++i) { const f32x4 q = sp[i]; ss += (q[0] + q[1]) + (q[2] + q[3]); }
            RS[tid] = __builtin_amdgcn_rsqf(ss * (1.0f / 2048.0f) + RMS_EPS); }
        __syncthreads();
        pg8::EpiGU E{(const float*)(ws + WS_SS1), (bf16_t*)(ws + WS_HIDDEN), RS, pm0};
        pg8::gemm_phase(lds, g, S, E); SYNC(8); }
    if (IN(9)) {
        pg8::Gemm g{(const bf16_t*)(ws + WS_HIDDEN), (const bf16_t*)(ws + WS_WD), FFN, FFN, FFN, 0}; pg8::StaticOrder S; S.init(RR, 2048, G, c);
        pg8::EpiDown E{(const bf16_t*)(ws + WS_H1B), (bf16_t*)(ws + WS_H2B)};
        pg8::gemm_phase(lds, g, S, E); SYNC(9); }
    if (IN(10)) final_phase(p, wv, lane);
#ifdef DIGEST_OFF
    if (lo <= 11 && 11 < hi) {
        const bf16_t* src = (const bf16_t*)(ws + (size_t)DIGEST_OFF * MiB);
        for (size_t i = (size_t)blockIdx.x * NTHREADS + tid; i < (size_t)RR * D; i += (size_t)gridDim.x * NTHREADS)
            p.out[i] = __uint_as_float((unsigned)src[(i * DIGEST_STRIDE) % (size_t)DIGEST_N] << 16);
    }
#endif
#undef IN
#undef SYNC
}

extern "C" void kernel_launch(void* const* d_in, const int* in_sizes, int n_in, void* d_out, int out_size, void* d_ws, size_t ws_size, hipStream_t stream) {
    static int grid = 0;
    if (grid == 0) {
        if (n_in != 18 || ws_size < WS_END) { fprintf(stderr, "kernel_launch: unexpected n_in %d or ws_size %zu\n", n_in, ws_size); grid = -1; return; }
        int dev = 0, cus = 0, per_cu = 0;
        hipGetDevice(&dev); hipDeviceGetAttribute(&cus, hipDeviceAttributeMultiprocessorCount, dev);
        if (hipFuncSetAttribute((const void*)fwd_kernel, hipFuncAttributeMaxDynamicSharedMemorySize, LDS_BYTES) != hipSuccess) { fprintf(stderr, "kernel_launch: hipFuncSetAttribute failed\n"); grid = -1; return; }
        hipOccupancyMaxActiveBlocksPerMultiprocessor(&per_cu, (const void*)fwd_kernel, NTHREADS, LDS_BYTES);
        (void)hipGetLastError();
        if (per_cu < 1) { fprintf(stderr, "kernel_launch: occupancy query says %d blocks per CU\n", per_cu); }
        grid = cus;
    }
    if (grid < 0) return;
    Params p{};
    p.x = (const float*)d_in[0]; p.meta = (const float*)d_in[1]; p.norm_mix_w = (const float*)d_in[2]; p.w_in = (const float*)d_in[3]; p.conv_w = (const float*)d_in[4];
    p.a_log = (const float*)d_in[5]; p.dt_bias = (const float*)d_in[6]; p.o_norm_w = (const float*)d_in[7]; p.w_proj_a = (const float*)d_in[8]; p.pool_w = (const float*)d_in[9];
    p.pool_scale = (const float*)d_in[10]; p.w_proj_b = (const float*)d_in[11]; p.w_out = (const float*)d_in[12]; p.norm_ffn_w = (const float*)d_in[13]; p.w_gate = (const float*)d_in[14];
    p.w_up = (const float*)d_in[15]; p.w_down = (const float*)d_in[16]; p.norm_final_w = (const float*)d_in[17];
    p.out = (float*)d_out; p.ws = (unsigned char*)d_ws;
#if MK_MULTI
    for (int ph = 0; ph <= 11; ++ph) { p.phase_lo = ph; p.phase_hi = ph + 1; hipLaunchKernelGGL(fwd_kernel, dim3(grid), dim3(NTHREADS), LDS_BYTES, stream, p); }
#else
    p.phase_lo = 0; p.phase_hi = 12;
    if (hipMemsetAsync(d_ws, 0, 16384, stream) != hipSuccess) { fprintf(stderr, "kernel_launch: memset of the barrier words failed\n"); return; }
    void* args[] = {&p};
    hipError_t e = hipLaunchCooperativeKernel((const void*)fwd_kernel, dim3(grid), dim3(NTHREADS), args, LDS_BYTES, stream);
    if (e != hipSuccess) fprintf(stderr, "cooperative launch failed: %s (grid %d)\n", hipGetErrorString(e), grid);
#endif
}
```

```cpp
#include <hip/hip_runtime.h>
#include <hip/hip_cooperative_groups.h>
#include <cstdio>
#include <cstdint>
namespace cg = cooperative_groups;

#define LAS __attribute__((address_space(3)))
typedef unsigned short bf16_t;
typedef short bf16x8 __attribute__((ext_vector_type(8)));
typedef float f32x4 __attribute__((ext_vector_type(4)));
typedef float f32x2 __attribute__((ext_vector_type(2)));
typedef unsigned u32x4 __attribute__((ext_vector_type(4)));
typedef unsigned u32x2 __attribute__((ext_vector_type(2)));

#ifndef MK_MULTI
#define MK_MULTI 0
#endif

constexpr int D = 2048, SEQ = 8192, NMETA = 16, TB = 8256  , RPV = 2 * TB  , RP = 16640  , RR = 16384;
constexpr int NCH = 129, NH = 8, HD = 128, NUNIT = 2 * NCH * NH  , UNIT_EL = 36864;
constexpr int FFN = 5632, NIN = 9472;
constexpr float RMS_EPS = 1e-6f, L2_EPS = 1e-6f;
constexpr int NTHREADS = 512;
constexpr int LDS_BYTES = 147456;

constexpr size_t MiB = 1u << 20;
constexpr size_t WS_BA = 1 * MiB, WS_GL = 2 * MiB + 512 * 1024, WS_SS1 = 3 * MiB;
constexpr size_t WS_WIN = 8 * MiB, WS_WA = 45 * MiB, WS_WB = 49 * MiB, WS_POOLT = 53 * MiB;
constexpr size_t WS_WOUT = 54 * MiB, WS_WGU = 62 * MiB, WS_WD = 106 * MiB;
constexpr size_t WS_PREPB = 128 * MiB;
constexpr size_t WS_HN = 128 * MiB, WS_QKV = 200 * MiB, WS_Z = 298 * MiB, WS_P = 331 * MiB, WS_GAB = 364 * MiB;
constexpr size_t WS_O = 200 * MiB, WS_OG = 233 * MiB, WS_POOLED = 266 * MiB, WS_ZB = 128 * MiB, WS_MERGED = 160 * MiB, WS_H1B = 364 * MiB, WS_HIDDEN = 128 * MiB;
constexpr size_t WS_H2B = 428 * MiB;
constexpr size_t WS_WEFF = 494 * MiB;
constexpr size_t WS_END = 498 * MiB;
static_assert(WS_PREPB + (size_t)NUNIT * 12288 * 2 <= WS_QKV && (size_t)NUNIT * 24576 * 2 <= (size_t)RR * D * 4, "prep records");
static_assert(WS_GAB + (size_t)RP * 4096 * 2 <= WS_END, "gab");
static_assert(WS_HIDDEN + (size_t)RR * FFN * 2 <= WS_H1B, "hidden");

struct Params {
    const float* x; const float* meta; const float* norm_mix_w; const float* w_in; const float* conv_w; const float* a_log; const float* dt_bias; const float* o_norm_w;
    const float* w_proj_a; const float* pool_w; const float* pool_scale; const float* w_proj_b; const float* w_out; const float* norm_ffn_w; const float* w_gate; const float* w_up;
    const float* w_down; const float* norm_final_w;
    float* out; unsigned char* ws;
    long long phase_lo, phase_hi;
};

typedef __bf16 bf16x2_t __attribute__((ext_vector_type(2)));
__device__ __forceinline__ unsigned cvt_pk_bf16(float lo, float hi) { const f32x2 v = {lo, hi}; const bf16x2_t b = __builtin_convertvector(v, bf16x2_t); return __builtin_bit_cast(unsigned, b); }
__device__ __forceinline__ float bf_lo(unsigned w) { return __uint_as_float(w << 16); }
__device__ __forceinline__ float bf_hi(unsigned w) { return __uint_as_float(w & 0xffff0000u); }
__device__ __forceinline__ float fast_sigmoid(float x) { return __builtin_amdgcn_rcpf(1.0f + __expf(-x)); }
__device__ __forceinline__ float fast_silu(float x) { return x * fast_sigmoid(x); }
__device__ __forceinline__ float wave_sum(float v) {
#pragma unroll
    for (int o = 1; o < 64; o <<= 1) v += __shfl_xor(v, o);
    return v;
}
#define LDS_WAIT() asm volatile("s_waitcnt lgkmcnt(0)" ::: "memory")

namespace pg8 {
constexpr int BM = 256, BK = 64, HALF = 128, HTB = HALF * BK * 2, STAGE_BYTES = 8 * HTB, NXCD = 8, WGM = 8;
__host__ __device__ __forceinline__ int lds_byte(int r, int c) { const int st = (r >> 4) * 2 + (c >> 5), rr = r & 15, cc = c & 31, ob = rr * 64 + cc * 2; return st * 1024 + (ob ^ (((ob >> 9) & 1) << 5)); }
__host__ __device__ __forceinline__ void stage_rc(int b, int& R, int& C) { const int st = b / 1024, sb = b % 1024, swz = sb ^ (((sb >> 9) & 1) << 5); R = (st >> 1) * 16 + swz / 64; C = (st & 1) * 32 + (swz % 64) / 2; }
__host__ __device__ __forceinline__ int perm32(int rho) { const int n = rho >> 4, i = rho & 15; return 8 * (i >> 2) + 4 * n + (i & 3); }

struct Unit { int pm, pn; };
struct Gemm { const bf16_t* A; const bf16_t* Bt; int lda, ldb, K, a_pn_off; };

struct StaticOrder {
    int nM, nN, nwg, G, c;
    __device__ void init(int M, int N, int G_, int c_) { nM = M / BM; nN = N / BM; nwg = nM * nN; G = G_; c = c_; }
    __device__ bool next(int i, Unit& u) const {
        const long L = (long)i * G + c; if (L >= nwg) return false;
        int wgid = (int)L; { const int q = nwg / NXCD, r = nwg % NXCD, xcd = wgid % NXCD, off = wgid / NXCD; wgid = (xcd < r ? xcd * (q + 1) : r * (q + 1) + (xcd - r) * q) + off; }
        const int nig = WGM * nN, gid = wgid / nig, fm = gid * WGM, gsz = (nM - fm) < WGM ? (nM - fm) : WGM;
        u.pm = fm + ((wgid % nig) % gsz); u.pn = (wgid % nig) / gsz; return true;
    }
};

template <class Epi>
__device__ __forceinline__ void gemm_phase(LAS unsigned char* lds, const Gemm g, const StaticOrder& S, const Epi& E) {
    const int tid = threadIdx.x, wid = __builtin_amdgcn_readfirstlane(tid >> 6), lane = tid & 63, wr = wid >> 2, wc = wid & 3, fr = lane & 15, fq = lane >> 4;
    const int nt = g.K / BK;
    unsigned voffA[2], voffB[2];
#pragma unroll
    for (int i = 0; i < 2; ++i) { int R, C; stage_rc(tid * 16 + i * 8192, R, C); const int Rb = (R & ~31) + perm32(R & 31);
        voffA[i] = (unsigned)(R * g.lda + C) * 2u; voffB[i] = (unsigned)(Rb * g.ldb + C) * 2u; }
    const size_t kstep = (size_t)(BK * 2);
    const size_t hstepA = (size_t)HALF * g.lda * 2, hstepB = (size_t)HALF * g.ldb * 2;
    const unsigned ldsw = (unsigned)wid * 1024u;
    const int aoff = lds_byte(wr * 64 + fr, fq * 8), boff = lds_byte(wc * 32 + fr, fq * 8);
#define PG8_SA(b, h) (((b) * 2 + (h)) * HTB)
#define PG8_SB(b, h) ((4 + (b) * 2 + (h)) * HTB)
#define PG8_STAGE(bufoff, gbase, voff) do { _Pragma("unroll") for (int _i = 0; _i < 2; ++_i) \
        __builtin_amdgcn_global_load_lds((const unsigned*)((const char*)(gbase) + (voff)[_i]), (LAS unsigned*)(lds + (bufoff) + ldsw + _i * 8192), 16, 0, 0); } while (0)
#define PG8_LDA(dst, b, h) do { _Pragma("unroll") for (int m = 0; m < 4; ++m) _Pragma("unroll") for (int k = 0; k < 2; ++k) dst[m][k] = *(const LAS bf16x8*)(lds + PG8_SA(b, h) + aoff + m * 2048 + k * 1024); } while (0)
#define PG8_LDB(dst, b, h) do { _Pragma("unroll") for (int n = 0; n < 2; ++n) _Pragma("unroll") for (int k = 0; k < 2; ++k) dst[n][k] = *(const LAS bf16x8*)(lds + PG8_SB(b, h) + boff + n * 2048 + k * 1024); } while (0)
#define PG8_MMA(ai, bj, At, Bt) do { __builtin_amdgcn_s_setprio(1); _Pragma("unroll") for (int m = 0; m < 4; ++m) _Pragma("unroll") for (int n = 0; n < 2; ++n) _Pragma("unroll") for (int k = 0; k < 2; ++k) \
        acc[ai][bj][m][n] = __builtin_amdgcn_mfma_f32_16x16x32_bf16(Bt[n][k], At[m][k], acc[ai][bj][m][n], 0, 0, 0); __builtin_amdgcn_s_setprio(0); } while (0)
#define PG8_WAIT_V(n) asm volatile("s_waitcnt vmcnt(" #n ")" ::: "memory")
#define PG8_WAIT_L(n) asm volatile("s_waitcnt lgkmcnt(" #n ")" ::: "memory")
#define PG8_BAR __builtin_amdgcn_s_barrier()
#define PG8_SCHED __builtin_amdgcn_sched_barrier(0)
    Unit cur, nxt; int ui = 0;
    if (!S.next(0, cur)) return;
    f32x4 acc[2][2][4][2];
#pragma unroll
    for (int a = 0; a < 2; ++a)
#pragma unroll
        for (int b = 0; b < 2; ++b)
#pragma unroll
            for (int m = 0; m < 4; ++m)
#pragma unroll
                for (int n = 0; n < 2; ++n) acc[a][b][m][n] = (f32x4){0.f, 0.f, 0.f, 0.f};
    bf16x8 At[4][2], B0[2][2], B1[2][2];
    const char* cA = (const char*)g.A + (size_t)cur.pm * 2 * hstepA + (size_t)cur.pn * g.a_pn_off * 2; const char* cB = (const char*)g.Bt + (size_t)cur.pn * 2 * hstepB;
    PG8_STAGE(PG8_SB(0, 0), cB, voffB); PG8_STAGE(PG8_SB(0, 1), cB + hstepB, voffB); PG8_STAGE(PG8_SA(0, 0), cA, voffA); PG8_STAGE(PG8_SA(0, 1), cA + hstepA, voffA);
    if (wr == 1) PG8_BAR;
    PG8_WAIT_V(2); PG8_BAR;
    PG8_STAGE(PG8_SB(1, 0), cB + kstep, voffB); PG8_STAGE(PG8_SA(1, 0), cA + kstep, voffA); PG8_STAGE(PG8_SB(1, 1), cB + hstepB + kstep, voffB);
    PG8_WAIT_V(6); PG8_BAR;
    for (;;) {
        const bool has_next = S.next(ui + 1, nxt);
        const char* nA = has_next ? (const char*)g.A + (size_t)nxt.pm * 2 * hstepA + (size_t)nxt.pn * g.a_pn_off * 2 : cA; const char* nB = has_next ? (const char*)g.Bt + (size_t)nxt.pn * 2 * hstepB : cB;
#pragma unroll 1
        for (int t = 0; t < nt; t += 2) {
            const bool last = (t == nt - 2);
            const char* a1 = cA + (size_t)(t + 1) * kstep;
            const char* a2 = last ? nA : cA + (size_t)(t + 2) * kstep; const char* b2 = last ? nB : cB + (size_t)(t + 2) * kstep;
            const char* a3 = a2 + kstep; const char* b3 = b2 + kstep;
            PG8_LDB(B0, 0, 0); PG8_LDB(B1, 0, 1); PG8_SCHED; PG8_LDA(At, 0, 0); PG8_STAGE(PG8_SA(1, 1), a1 + hstepA, voffA);
            PG8_WAIT_V(8); PG8_WAIT_L(0); PG8_BAR; PG8_MMA(0, 0, At, B0); PG8_MMA(0, 1, At, B1); PG8_BAR; PG8_SCHED;
            PG8_LDA(At, 0, 1); PG8_STAGE(PG8_SB(0, 0), b2, voffB); PG8_STAGE(PG8_SB(0, 1), b2 + hstepB, voffB); PG8_STAGE(PG8_SA(0, 0), a2, voffA);
            PG8_WAIT_V(8); PG8_WAIT_L(0); PG8_BAR; PG8_MMA(1, 0, At, B0); PG8_MMA(1, 1, At, B1); PG8_BAR; PG8_SCHED;
            PG8_LDB(B0, 1, 0); PG8_LDB(B1, 1, 1); PG8_SCHED; PG8_LDA(At, 1, 0); PG8_STAGE(PG8_SA(0, 1), a2 + hstepA, voffA);
            PG8_WAIT_V(8); PG8_WAIT_L(0); PG8_BAR; PG8_MMA(0, 0, At, B0); PG8_MMA(0, 1, At, B1); PG8_BAR; PG8_SCHED;
            PG8_LDA(At, 1, 1); PG8_STAGE(PG8_SB(1, 0), b3, voffB); PG8_STAGE(PG8_SB(1, 1), b3 + hstepB, voffB); PG8_STAGE(PG8_SA(1, 0), a3, voffA);
            PG8_WAIT_V(8); PG8_WAIT_L(0); PG8_BAR; PG8_MMA(1, 0, At, B0); PG8_MMA(1, 1, At, B1); PG8_BAR; PG8_SCHED;
        }
        if (wr == 0) PG8_BAR;
        E(acc, cur, wr, wc, fr, fq);
        if (!has_next) break;
#pragma unroll
        for (int a = 0; a < 2; ++a)
#pragma unroll
            for (int b = 0; b < 2; ++b)
#pragma unroll
                for (int m = 0; m < 4; ++m)
#pragma unroll
                    for (int n = 0; n < 2; ++n) acc[a][b][m][n] = (f32x4){0.f, 0.f, 0.f, 0.f};
        cur = nxt; cA = nA; cB = nB; ++ui;
        if (wr == 1) PG8_BAR;
    }
    PG8_WAIT_V(0);
    PG8_BAR;
#undef PG8_SA
#undef PG8_SB
#undef PG8_STAGE
#undef PG8_LDA
#undef PG8_LDB
#undef PG8_MMA
#undef PG8_WAIT_V
#undef PG8_WAIT_L
#undef PG8_BAR
#undef PG8_SCHED
}

typedef f32x4 AccT[2][2][4][2];
template <int ACT  >
__device__ __forceinline__ void store_tile_bf16(const AccT& acc, bf16_t* base  , int ld, int row0) {
#pragma unroll
    for (int ai = 0; ai < 2; ++ai)
#pragma unroll
        for (int m = 0; m < 4; ++m) { bf16_t* rowp = base + (size_t)(row0 + ai * HALF + m * 16) * ld;
#pragma unroll
            for (int bj = 0; bj < 2; ++bj) { f32x4 v0 = acc[ai][bj][m][0], v1 = acc[ai][bj][m][1];
                if (ACT == 1) { for (int i = 0; i < 4; ++i) { v0[i] = fast_silu(v0[i]); v1[i] = fast_silu(v1[i]); } }
                if (ACT == 2) { for (int i = 0; i < 4; ++i) { v0[i] = fast_sigmoid(v0[i]); v1[i] = fast_sigmoid(v1[i]); } }
                u32x4 w; w.x = cvt_pk_bf16(v0[0], v0[1]); w.y = cvt_pk_bf16(v0[2], v0[3]); w.z = cvt_pk_bf16(v1[0], v1[1]); w.w = cvt_pk_bf16(v1[2], v1[3]);
                *(u32x4*)(rowp + bj * HALF) = w; } }
}
__device__ __forceinline__ unsigned q8(float x) { return (unsigned)(fast_sigmoid(x) * 255.0f + 0.5f); }
__device__ __forceinline__ void store_tile_gate_u8(const AccT& acc, unsigned char* base  , int row0) {
#pragma unroll
    for (int ai = 0; ai < 2; ++ai)
#pragma unroll
        for (int m = 0; m < 4; ++m) { unsigned char* rowp = base + (size_t)(row0 + ai * HALF + m * 16) * 4096;
#pragma unroll
            for (int bj = 0; bj < 2; ++bj) { const f32x4 v0 = acc[ai][bj][m][0], v1 = acc[ai][bj][m][1];
                u32x2 w; w.x = q8(v0[0]) | (q8(v0[1]) << 8) | (q8(v0[2]) << 16) | (q8(v0[3]) << 24); w.y = q8(v1[0]) | (q8(v1[1]) << 8) | (q8(v1[2]) << 16) | (q8(v1[3]) << 24);
                *(u32x2*)(rowp + bj * HALF) = w; } }
}
struct EpiIn {
    bf16_t* QKV; bf16_t* Z; bf16_t* P; unsigned char* GAB; float* BA;
    __device__ __forceinline__ void operator()(const AccT& acc, const Unit& u, int wr, int wc, int fr, int fq) const {
        const int pn = u.pn, row0 = u.pm * BM + wr * 64 + fr, cl = wc * 32 + 8 * fq;
        if (pn == 36) {
            if (wc == 0 && fq < 2) {
#pragma unroll
                for (int ai = 0; ai < 2; ++ai)
#pragma unroll
                    for (int m = 0; m < 4; ++m) { float* q = BA + (size_t)(row0 + ai * HALF + m * 16) * 16 + 8 * fq; *(f32x4*)q = acc[ai][0][m][0]; *(f32x4*)(q + 4) = acc[ai][0][m][1]; }
            }
            return;
        }
        if (pn < 12) store_tile_bf16<0>(acc, QKV + pn * 256 + cl, 3072, row0);
        else if (pn < 16) store_tile_bf16<1>(acc, Z + (pn - 12) * 256 + cl, 1024, row0);
        else if (pn < 20) store_tile_bf16<0>(acc, P + (pn - 16) * 256 + cl, 1024, row0);
        else store_tile_gate_u8(acc, GAB + (pn - 20) * 256 + cl, row0);
    }
};
struct EpiPlain {
    bf16_t* O; int ld;
    __device__ __forceinline__ void operator()(const AccT& acc, const Unit& u, int wr, int wc, int fr, int fq) const {
        store_tile_bf16<0>(acc, O + u.pn * 256 + wc * 32 + 8 * fq, ld, u.pm * BM + wr * 64 + fr);
    }
};
template <bool SECOND> struct EpiMerge {
    const unsigned char* GAB; bf16_t* MERGED;
    __device__ __forceinline__ void operator()(const AccT& acc, const Unit& u, int wr, int wc, int fr, int fq) const {
        const int row0 = u.pm * BM + wr * 64 + fr, cl = u.pn * 256 + wc * 32 + 8 * fq;
#pragma unroll
        for (int ai = 0; ai < 2; ++ai)
#pragma unroll
            for (int m = 0; m < 4; ++m) { const int rr = row0 + ai * HALF + m * 16; const int prow = rr + 64 + ((rr >> 13) << 6);
                const unsigned char* gp = GAB + (size_t)prow * 4096 + (SECOND ? 2048 : 0) + cl; bf16_t* mp = MERGED + (size_t)rr * 2048 + cl;
#pragma unroll
                for (int bj = 0; bj < 2; ++bj) { const u32x2 gw = *(const u32x2*)(gp + bj * HALF); const f32x4 v0 = acc[ai][bj][m][0] * (1.0f / 255.0f), v1 = acc[ai][bj][m][1] * (1.0f / 255.0f);
                    float r0 = (float)(gw.x & 0xffu) * v0[0], r1 = (float)((gw.x >> 8) & 0xffu) * v0[1], r2 = (float)((gw.x >> 16) & 0xffu) * v0[2], r3 = (float)(gw.x >> 24) * v0[3];
                    float r4 = (float)(gw.y & 0xffu) * v1[0], r5 = (float)((gw.y >> 8) & 0xffu) * v1[1], r6 = (float)((gw.y >> 16) & 0xffu) * v1[2], r7 = (float)(gw.y >> 24) * v1[3];
                    if (SECOND) { const u32x4 mw = *(const u32x4*)(mp + bj * HALF);
                        r0 += bf_lo(mw.x); r1 += bf_hi(mw.x); r2 += bf_lo(mw.y); r3 += bf_hi(mw.y); r4 += bf_lo(mw.z); r5 += bf_hi(mw.z); r6 += bf_lo(mw.w); r7 += bf_hi(mw.w); }
                    u32x4 w; w.x = cvt_pk_bf16(r0, r1); w.y = cvt_pk_bf16(r2, r3); w.z = cvt_pk_bf16(r4, r5); w.w = cvt_pk_bf16(r6, r7);
                    *(u32x4*)(mp + bj * HALF) = w; } }
    }
};
struct EpiOut {
    const float* x; bf16_t* H1B; float* SS1;
    __device__ __forceinline__ void operator()(const AccT& acc, const Unit& u, int wr, int wc, int fr, int fq) const {
        const int row0 = u.pm * BM + wr * 64 + fr, cl = u.pn * 256 + wc * 32 + 8 * fq;
#pragma unroll
        for (int ai = 0; ai < 2; ++ai)
#pragma unroll
            for (int m = 0; m < 4; ++m) { const int rr = row0 + ai * HALF + m * 16; const size_t off = (size_t)rr * 2048 + cl; float ss = 0.f;
#pragma unroll
                for (int bj = 0; bj < 2; ++bj) { const f32x4 x0 = *(const f32x4*)(x + off + bj * HALF), x1 = *(const f32x4*)(x + off + bj * HALF + 4);
                    const f32x4 h0 = x0 + acc[ai][bj][m][0], h1 = x1 + acc[ai][bj][m][1];
                    ss += (h0[0] * h0[0] + h0[1] * h0[1]) + (h0[2] * h0[2] + h0[3] * h0[3]) + (h1[0] * h1[0] + h1[1] * h1[1]) + (h1[2] * h1[2] + h1[3] * h1[3]);
                    u32x4 w; w.x = cvt_pk_bf16(h0[0], h0[1]); w.y = cvt_pk_bf16(h0[2], h0[3]); w.z = cvt_pk_bf16(h1[0], h1[1]); w.w = cvt_pk_bf16(h1[2], h1[3]);
                    *(u32x4*)(H1B + off + bj * HALF) = w; }
                ss += __shfl_xor(ss, 16); ss += __shfl_xor(ss, 32);
                if (fq == 0) SS1[(size_t)rr * 32 + u.pn * 4 + wc] = ss; }
    }
};
struct EpiGU {
    const float* SS1; bf16_t* HID; const LAS float* RS; int pm0;
    __device__ __forceinline__ void operator()(const AccT& acc, const Unit& u, int wr, int wc, int fr, int fq) const {
        const int row0 = u.pm * BM + wr * 64 + fr, cl = u.pn * 128 + wc * 32 + 8 * fq;
#pragma unroll
        for (int ai = 0; ai < 2; ++ai)
#pragma unroll
            for (int m = 0; m < 4; ++m) { const int rr = row0 + ai * HALF + m * 16; float rstd;
                if (u.pm == pm0) rstd = RS[ai * HALF + wr * 64 + m * 16 + fr];
                else { const f32x4* sp = (const f32x4*)(SS1 + (size_t)rr * 32) + 2 * fq; float ss;
                    { const f32x4 s0 = sp[0], s1 = sp[1]; ss = ((s0[0] + s0[1]) + (s0[2] + s0[3])) + ((s1[0] + s1[1]) + (s1[2] + s1[3])); }
                    ss += __shfl_xor(ss, 16); ss += __shfl_xor(ss, 32);
                    rstd = __builtin_amdgcn_rsqf(ss * (1.0f / 2048.0f) + RMS_EPS); }
                const f32x4 g0 = acc[ai][0][m][0] * rstd, g1 = acc[ai][0][m][1] * rstd, u0 = acc[ai][1][m][0] * rstd, u1 = acc[ai][1][m][1] * rstd;
                u32x4 w; w.x = cvt_pk_bf16(fast_silu(g0[0]) * u0[0], fast_silu(g0[1]) * u0[1]); w.y = cvt_pk_bf16(fast_silu(g0[2]) * u0[2], fast_silu(g0[3]) * u0[3]);
                w.z = cvt_pk_bf16(fast_silu(g1[0]) * u1[0], fast_silu(g1[1]) * u1[1]); w.w = cvt_pk_bf16(fast_silu(g1[2]) * u1[2], fast_silu(g1[3]) * u1[3]);
                *(u32x4*)(HID + (size_t)rr * FFN + cl) = w; }
    }
};
struct EpiDown {
    const bf16_t* H1B; bf16_t* H2B;
    __device__ __forceinline__ void operator()(const AccT& acc, const Unit& u, int wr, int wc, int fr, int fq) const {
        const int row0 = u.pm * BM + wr * 64 + fr, cl = u.pn * 256 + wc * 32 + 8 * fq;
#pragma unroll
        for (int ai = 0; ai < 2; ++ai)
#pragma unroll
            for (int m = 0; m < 4; ++m) { const size_t off = (size_t)(row0 + ai * HALF + m * 16) * 2048 + cl;
#pragma unroll
                for (int bj = 0; bj < 2; ++bj) { const u32x4 hw = *(const u32x4*)(H1B + off + bj * HALF); const f32x4 v0 = acc[ai][bj][m][0], v1 = acc[ai][bj][m][1];
                    u32x4 w; w.x = cvt_pk_bf16(bf_lo(hw.x) + v0[0], bf_hi(hw.x) + v0[1]); w.y = cvt_pk_bf16(bf_lo(hw.y) + v0[2], bf_hi(hw.y) + v0[3]);
                    w.z = cvt_pk_bf16(bf_lo(hw.z) + v1[0], bf_hi(hw.z) + v1[1]); w.w = cvt_pk_bf16(bf_lo(hw.w) + v1[2], bf_hi(hw.w) + v1[3]);
                    *(u32x4*)(H2B + off + bj * HALF) = w; } }
    }
};
}

constexpr int TR_LDS = 64 * 65 * 4;
struct TrDesc { const float* src; bf16_t* dst; const float* kscale; int ldw, ncols, ldk; };
struct TrRegs { f32x4 v[16]; float ks; };
__device__ __forceinline__ void tr_load(const TrDesc& d, TrRegs& R, int lane) {
    const int r4 = lane >> 4, cq = lane & 15;
    const bool on = 4 * cq < d.ncols;
    const float* sp = d.src + (size_t)r4 * d.ldw + (on ? 4 * cq : 0);
#pragma unroll
    for (int it = 0; it < 16; ++it) { const f32x4 x = *(const f32x4*)(sp + (size_t)(4 * it) * d.ldw); R.v[it] = on ? x : (f32x4){0.f, 0.f, 0.f, 0.f}; }
    R.ks = d.kscale ? d.kscale[lane] : 1.0f;
}
__device__ __forceinline__ void tr_finish(const TrDesc& d, const TrRegs& R, LAS float* scr, int lane, bool valid) {
    const int r4 = lane >> 4, cq = lane & 15;
#pragma unroll
    for (int it = 0; it < 16; ++it) { const int kk = 4 * it + r4; const float kv = __shfl(R.ks, kk); const f32x4 v = R.v[it] * kv;
        LAS float* q = scr + kk * 65 + 4 * cq; q[0] = v[0]; q[1] = v[1]; q[2] = v[2]; q[3] = v[3]; }
    LDS_WAIT(); asm volatile("" ::: "memory");
    const int cc = lane & 7;
#pragma unroll
    for (int j = 0; j < 8; ++j) { const int n = (lane >> 3) + 8 * j; const LAS float* sp = scr + (8 * cc) * 65 + n;
        u32x4 o; o.x = cvt_pk_bf16(sp[0 * 65], sp[1 * 65]); o.y = cvt_pk_bf16(sp[2 * 65], sp[3 * 65]); o.z = cvt_pk_bf16(sp[4 * 65], sp[5 * 65]); o.w = cvt_pk_bf16(sp[6 * 65], sp[7 * 65]);
        if (valid) *(u32x4*)(d.dst + (size_t)n * d.ldk + 8 * cc) = o; }
    LDS_WAIT(); asm volatile("" ::: "memory");
}
constexpr int EARLY_ITEMS = 148 * 32 + 32 * 16 + 32 * 16;
__device__ __forceinline__ TrDesc early_desc(const Params& p, int r) {
    unsigned char* ws = p.ws; TrDesc d; d.kscale = nullptr;
    constexpr int I_IN = 148 * 32, I_A = 32 * 16;
    if (r < I_IN) { const int rb = r / 32, kb = r % 32, dst = rb * 64; int src, nc;
        if (dst < 9216) { src = dst + (dst >= 4096 ? 16 : 0); nc = 64; } else if (dst == 9216) { src = 4096; nc = 16; } else { src = 0; nc = 0; }
        d.src = p.w_in + (size_t)(kb * 64) * 9232 + src; d.ldw = 9232; d.ncols = nc; d.dst = (bf16_t*)(ws + WS_WIN) + (size_t)dst * 2048 + kb * 64; d.ldk = 2048; return d; }
    r -= I_IN;
    const bool isb = r >= I_A; if (isb) r -= I_A;
    const int rb = r / 16, kb = r % 16;
    d.src = (isb ? p.w_proj_b : p.w_proj_a) + (size_t)(kb * 64) * 2048 + rb * 64; d.ldw = 2048; d.ncols = 64; d.dst = (bf16_t*)(ws + (isb ? WS_WB : WS_WA)) + (size_t)(rb * 64) * 1024 + kb * 64; d.ldk = 1024; return d;
}
constexpr int LATE_ITEMS = 32 * 32 + 2 * 88 * 32 + 32 * 88;
__device__ __forceinline__ TrDesc late_desc(const Params& p, int r) {
    unsigned char* ws = p.ws; TrDesc d; d.kscale = nullptr;
    constexpr int I_O = 32 * 32, I_G = 88 * 32;
    if (r < I_O) { const int rb = r / 32, kb = r % 32; d.src = p.w_out + (size_t)(kb * 64) * 2048 + rb * 64; d.ldw = 2048; d.ncols = 64; d.dst = (bf16_t*)(ws + WS_WOUT) + (size_t)(rb * 64) * 2048 + kb * 64; d.ldk = 2048; return d; }
    r -= I_O;
    if (r < 2 * I_G) { const bool up = r >= I_G; if (up) r -= I_G; const int rb = r / 32, kb = r % 32, j0 = rb * 64; const int dst = (j0 / 128) * 256 + (j0 % 128) + (up ? 128 : 0);
        d.src = (up ? p.w_up : p.w_gate) + (size_t)(kb * 64) * FFN + j0; d.ldw = FFN; d.ncols = 64; d.dst = (bf16_t*)(ws + WS_WGU) + (size_t)dst * 2048 + kb * 64; d.ldk = 2048; d.kscale = p.norm_ffn_w + kb * 64; return d; }
    r -= 2 * I_G;
    { const int rb = r / 88, kb = r % 88; d.src = p.w_down + (size_t)(kb * 64) * 2048 + rb * 64; d.ldw = 2048; d.ncols = 64; d.dst = (bf16_t*)(ws + WS_WD) + (size_t)(rb * 64) * FFN + kb * 64; d.ldk = FFN; return d; }
}
template <bool LATE>
__device__ __forceinline__ void convert_weights(const Params& p, LAS unsigned char* lds, int wv, int lane, int wg0, int nwg) {
    LAS float* scr = (LAS float*)(lds + wv * TR_LDS);
    const int gw = ((int)blockIdx.x - wg0) * 8 + wv, NGW = nwg * 8;
    constexpr int NI = LATE ? LATE_ITEMS : EARLY_ITEMS;
    const int trips = (NI + NGW - 1) / NGW;
#define TR_DESC(i_) (LATE ? late_desc(p, (i_) < NI ? (i_) : NI - 1) : early_desc(p, (i_) < NI ? (i_) : NI - 1))
    TrDesc d0 = TR_DESC(gw), d1 = TR_DESC(gw + NGW);
    TrRegs r0, r1;
    tr_load(d0, r0, lane); tr_load(d1, r1, lane);
    for (int k = 0; k < trips; k += 2) {
        const int i0 = gw + k * NGW, i1 = i0 + NGW;
        tr_finish(d0, r0, scr, lane, i0 < NI);
        d0 = TR_DESC(i0 + 2 * NGW); tr_load(d0, r0, lane);
        tr_finish(d1, r1, scr, lane, (k + 1 < trips) && i1 < NI);
        d1 = TR_DESC(i1 + 2 * NGW); tr_load(d1, r1, lane);
    }
#undef TR_DESC
}

__device__ __forceinline__ void phase0(const Params& p, LAS unsigned char* lds, int wv, int lane) {
    unsigned char* ws = p.ws;
    const int gw = blockIdx.x * 8 + wv, NGW = gridDim.x * 8;
    convert_weights<false>(p, lds, wv, lane, 0, (int)gridDim.x);
    { bf16_t* PB = (bf16_t*)(ws + WS_POOLT);
      for (int i = blockIdx.x * NTHREADS + threadIdx.x; i < 4 * 256 * 256 / 4; i += gridDim.x * NTHREADS) {
          const int e = 4 * i, g = e >> 16, d = e & 255; const f32x4 v = *(const f32x4*)(p.pool_w + e); const f32x4 sc = *(const f32x4*)(p.pool_scale + g * 256 + d);
          u32x2 o; o.x = cvt_pk_bf16(v[0] * sc[0], v[1] * sc[1]); o.y = cvt_pk_bf16(v[2] * sc[2], v[3] * sc[3]); *(u32x2*)(PB + e) = o; } }
    bf16_t* HN = (bf16_t*)(ws + WS_HN);
    for (int row = gw; row < RP; row += NGW) {
        const float* src = nullptr;
        if (row < RPV) { const int b = row / TB, pos = row - b * TB; if (pos >= 64) src = p.x + (size_t)(b * SEQ + pos - 64) * D; else if (pos >= 48) src = p.meta + (size_t)(pos - 48) * D; }
        u32x2* o8 = (u32x2*)(HN + (size_t)row * D) + lane;
        if (!src) {
#pragma unroll
            for (int j = 0; j < 8; ++j) o8[64 * j] = (u32x2){0u, 0u};
        } else {
            const f32x4* xr = (const f32x4*)src + lane; const f32x4* wr_ = (const f32x4*)p.norm_mix_w + lane;
            f32x4 v[8]; float s = 0.f;
#pragma unroll
            for (int j = 0; j < 8; ++j) { v[j] = xr[64 * j]; s += (v[j][0] * v[j][0] + v[j][1] * v[j][1]) + (v[j][2] * v[j][2] + v[j][3] * v[j][3]); }
            const float rstd = __builtin_amdgcn_rsqf(wave_sum(s) * (1.0f / D) + RMS_EPS);
#pragma unroll
            for (int j = 0; j < 8; ++j) { const f32x4 w = wr_[64 * j]; u32x2 o; o.x = cvt_pk_bf16(v[j][0] * rstd * w[0], v[j][1] * rstd * w[1]); o.y = cvt_pk_bf16(v[j][2] * rstd * w[2], v[j][3] * rstd * w[3]); o8[64 * j] = o; }
        }
    }
}

__device__ __forceinline__ void prep_phase(const Params& p, LAS unsigned char* lds, int wv, int lane_in, int n_lo, int n_hi, int w, int nw) {
    unsigned char* ws = p.ws;
    LAS float* AM = (LAS float*)(lds);
    LAS bf16_t* TM = (LAS bf16_t*)(lds + 17408);
    LAS bf16_t* QN = (LAS bf16_t*)(lds + 26624);
    LAS bf16_t* KN = (LAS bf16_t*)(lds + 44032);
    LAS bf16_t* KBT = (LAS bf16_t*)(lds + 61440);
    LAS bf16_t* VBT = (LAS bf16_t*)(lds + 79872);
    const bf16_t* QKV = (const bf16_t*)(ws + WS_QKV); const float* BA = (const float*)(ws + WS_BA); float* GL = (float*)(ws + WS_GL);
    const float qscale = 0.08838834764831845f;
    for (int ui = w; ui < (n_hi - n_lo) * 16; ui += nw) {
        const int n = n_lo + (ui >> 4), b = (ui >> 3) & 1, h = ui & 7;
        const int r0 = b * TB + n * 64;
        int lane = lane_in; asm volatile("" : "+v"(lane));
        const int fr = lane & 15, fq = lane >> 4;
        const int urec = (b * NH + h) * NCH + n;
        bf16_t* UA = (bf16_t*)p.out + (size_t)urec * 24576; bf16_t* UB = (bf16_t*)(ws + WS_PREPB) + (size_t)urec * 12288;
        bf16_t* uT = UA; bf16_t* wM = UA + 8192; bf16_t* qd = UA + 16384; bf16_t* kdT = UB; bf16_t* qkM = UB + 8192;
        float beta, gc, gcl;
        { const float bl = BA[(size_t)(r0 + lane) * 16 + h], al = BA[(size_t)(r0 + lane) * 16 + 8 + h];
          const bool valid = !(n == 0 && lane < 48);
          const float xg = al + p.dt_bias[h]; const float sp = fmaxf(xg, 0.f) + log1pf(expf(-fabsf(xg)));
          float g = valid ? -expf(p.a_log[h]) * sp : 0.f;
          beta = valid ? 1.0f / (1.0f + expf(-bl)) : 0.f;
#pragma unroll
          for (int o = 1; o < 64; o <<= 1) { const float t = __shfl_up(g, o); if (lane >= o) g += t; }
          gc = g; gcl = __shfl(gc, 63); }
        {
            const int t0 = wv * 8;
            unsigned xin[3][11]; float cw[3][4][2];
#pragma unroll
            for (int c3 = 0; c3 < 3; ++c3) {
#pragma unroll
                for (int i = 0; i < 11; ++i) { const int grow = r0 + t0 - 3 + i; xin[c3][i] = (grow >= 0) ? *(const unsigned*)(QKV + (size_t)grow * 3072 + c3 * 1024 + h * 128 + 2 * lane) : 0u; }
#pragma unroll
                for (int j = 0; j < 4; ++j) { const f32x2 w2 = *(const f32x2*)(p.conv_w + (size_t)j * 3072 + c3 * 1024 + h * 128 + 2 * lane); cw[c3][j][0] = w2[0]; cw[c3][j][1] = w2[1]; }
            }
            float kb[2][8], vb[2][8], kd[2][8];
            float y[8][3][2], ssq[8], ssk[8];
#pragma unroll
            for (int i = 0; i < 8; ++i) {
#pragma unroll
                for (int c3 = 0; c3 < 3; ++c3) { float a0 = 0.f, a1 = 0.f;
#pragma unroll
                    for (int j = 0; j < 4; ++j) { a0 += cw[c3][j][0] * bf_lo(xin[c3][i + j]); a1 += cw[c3][j][1] * bf_hi(xin[c3][i + j]); }
                    y[i][c3][0] = fast_silu(a0); y[i][c3][1] = fast_silu(a1); }
                ssq[i] = y[i][0][0] * y[i][0][0] + y[i][0][1] * y[i][0][1]; ssk[i] = y[i][1][0] * y[i][1][0] + y[i][1][1] * y[i][1][1];
            }
#pragma unroll
            for (int o = 1; o < 64; o <<= 1) {
#pragma unroll
                for (int i = 0; i < 8; ++i) { ssq[i] += __shfl_xor(ssq[i], o); ssk[i] += __shfl_xor(ssk[i], o); }
            }
#pragma unroll
            for (int i = 0; i < 8; ++i) {
                const int t = t0 + i;
                const float rq = __builtin_amdgcn_rsqf(ssq[i] + L2_EPS) * qscale, rk = __builtin_amdgcn_rsqf(ssk[i] + L2_EPS);
                const float bt = __shfl(beta, t), gct = __shfl(gc, t);
                const float eg = __expf(gct), egl = __expf(gcl - gct);
                const float q0 = y[i][0][0] * rq, q1 = y[i][0][1] * rq, k0 = y[i][1][0] * rk, k1 = y[i][1][1] * rk;
                *(LAS unsigned*)(QN + t * 136 + 2 * lane) = cvt_pk_bf16(q0, q1);
                *(LAS unsigned*)(KN + t * 136 + 2 * lane) = cvt_pk_bf16(k0, k1);
                *(unsigned*)(qd + ((((t >> 4) * 4 + (lane >> 4)) * 64 + ((lane & 15) >> 2) * 16 + (t & 15)) * 8 + 2 * (lane & 3))) = cvt_pk_bf16(q0 * eg, q1 * eg);
                kb[0][i] = k0 * bt * eg; kb[1][i] = k1 * bt * eg; vb[0][i] = y[i][2][0] * bt; vb[1][i] = y[i][2][1] * bt; kd[0][i] = k0 * egl; kd[1][i] = k1 * egl;
            }
#pragma unroll
            for (int ch = 0; ch < 2; ++ch) { const int d = 2 * lane + ch; u32x4 a, v, k;
                a.x = cvt_pk_bf16(kb[ch][0], kb[ch][1]); a.y = cvt_pk_bf16(kb[ch][2], kb[ch][3]); a.z = cvt_pk_bf16(kb[ch][4], kb[ch][5]); a.w = cvt_pk_bf16(kb[ch][6], kb[ch][7]);
                v.x = cvt_pk_bf16(vb[ch][0], vb[ch][1]); v.y = cvt_pk_bf16(vb[ch][2], vb[ch][3]); v.z = cvt_pk_bf16(vb[ch][4], vb[ch][5]); v.w = cvt_pk_bf16(vb[ch][6], vb[ch][7]);
                k.x = cvt_pk_bf16(kd[ch][0], kd[ch][1]); k.y = cvt_pk_bf16(kd[ch][2], kd[ch][3]); k.z = cvt_pk_bf16(kd[ch][4], kd[ch][5]); k.w = cvt_pk_bf16(kd[ch][6], kd[ch][7]);
                *(LAS u32x4*)(KBT + d * 72 + t0) = a; *(LAS u32x4*)(VBT + d * 72 + t0) = v;
                *(u32x4*)(kdT + ((((d >> 4) * 2 + (wv >> 2)) * 64 + (wv & 3) * 16 + (d & 15)) * 8)) = k; }
        }
        __syncthreads();
        {
            const int it = wv >> 1;
#pragma unroll
            for (int jj = 0; jj < 2; ++jj) { const int jt = (wv & 1) * 2 + jj;
                f32x4 akk = (f32x4){0.f, 0.f, 0.f, 0.f}, aqk = (f32x4){0.f, 0.f, 0.f, 0.f};
#pragma unroll
                for (int kk = 0; kk < 4; ++kk) {
                    const bf16x8 kni = *(const LAS bf16x8*)(KN + (it * 16 + fr) * 136 + kk * 32 + fq * 8);
                    const bf16x8 knj = *(const LAS bf16x8*)(KN + (jt * 16 + fr) * 136 + kk * 32 + fq * 8);
                    const bf16x8 qni = *(const LAS bf16x8*)(QN + (it * 16 + fr) * 136 + kk * 32 + fq * 8);
                    akk = __builtin_amdgcn_mfma_f32_16x16x32_bf16(kni, knj, akk, 0, 0, 0);
                    aqk = __builtin_amdgcn_mfma_f32_16x16x32_bf16(knj, qni, aqk, 0, 0, 0);
                }
                { const int j = jt * 16 + fr; const float gj = __shfl(gc, j);
#pragma unroll
                  for (int r = 0; r < 4; ++r) { const int i = it * 16 + fq * 4 + r; const float gi = __shfl(gc, i), bi = __shfl(beta, i);
                      AM[i * 68 + j] = (j < i) ? bi * akk[r] * expf(gi - gj) : 0.f; } }
                { const int i = it * 16 + fr; const float gi = __shfl(gc, i); float v[4];
#pragma unroll
                  for (int r = 0; r < 4; ++r) { const int j = jt * 16 + fq * 4 + r; const float gj = __shfl(gc, j); v[r] = (j <= i) ? aqk[r] * expf(gi - gj) : 0.f; }
                  u32x2 w; w.x = cvt_pk_bf16(v[0], v[1]); w.y = cvt_pk_bf16(v[2], v[3]);
                  *(u32x2*)(qkM + (((it * 2 + (jt >> 1)) * 64 + ((jt & 1) * 2 + (fq >> 1)) * 16 + fr) * 8 + (fq & 1) * 4)) = w; }
            }
        }
        __syncthreads();
        {
            LAS bf16_t* T11T = (LAS bf16_t*)(lds + 98304);
            LAS bf16_t* A21B = (LAS bf16_t*)(lds + 100864);
            LAS bf16_t* XT = (LAS bf16_t*)(lds + 103424);
            if (wv < 2) {
                const int o = wv * 32, c = lane & 31;
                float t[32];
#pragma unroll
                for (int i = 0; i < 32; ++i) {
                    float a0 = (c == i) ? 1.f : 0.f, a1 = 0.f, a2 = 0.f, a3 = 0.f;
#pragma unroll
                    for (int j = 0; j < (i & ~3); j += 4) { const f32x4 av = *(const LAS f32x4*)(AM + (o + i) * 68 + o + j); a0 -= av[0] * t[j]; a1 -= av[1] * t[j + 1]; a2 -= av[2] * t[j + 2]; a3 -= av[3] * t[j + 3]; }
#pragma unroll
                    for (int j = (i & ~3); j < i; ++j) a0 -= AM[(o + i) * 68 + o + j] * t[j];
                    t[i] = (a0 + a1) + (a2 + a3);
                    if (lane < 32) TM[(o + i) * 72 + o + c] = (bf16_t)(cvt_pk_bf16(t[i], 0.f) & 0xffffu);
                    else if (wv == 0) TM[i * 72 + lane] = (bf16_t)0;
                    asm volatile("" ::: "memory");
                }
                if (wv == 0 && lane < 32) {
#pragma unroll
                    for (int q = 0; q < 4; ++q) { u32x4 w; w.x = cvt_pk_bf16(t[8 * q], t[8 * q + 1]); w.y = cvt_pk_bf16(t[8 * q + 2], t[8 * q + 3]); w.z = cvt_pk_bf16(t[8 * q + 4], t[8 * q + 5]); w.w = cvt_pk_bf16(t[8 * q + 6], t[8 * q + 7]);
                        *(LAS u32x4*)(T11T + c * 40 + 8 * q) = w; }
                }
                if (wv == 0 && lane == 0) GL[urec] = expf(gcl);
            } else if (wv < 6) {
                const int e = (wv - 2) * 256 + lane * 4, i = e >> 5, k = e & 31;
                const f32x4 v = *(const LAS f32x4*)(AM + (32 + i) * 68 + k);
                u32x2 w; w.x = cvt_pk_bf16(v[0], v[1]); w.y = cvt_pk_bf16(v[2], v[3]);
                *(LAS u32x2*)(A21B + i * 40 + k) = w;
            }
            __syncthreads();
            const int it2 = (wv >> 1) & 1, jt2 = wv & 1;
            if (wv < 4) {
                const bf16x8 xa = *(const LAS bf16x8*)(A21B + (it2 * 16 + fr) * 40 + fq * 8);
                const bf16x8 yb = *(const LAS bf16x8*)(T11T + (jt2 * 16 + fr) * 40 + fq * 8);
                const f32x4 x = __builtin_amdgcn_mfma_f32_16x16x32_bf16(xa, yb, (f32x4){0.f, 0.f, 0.f, 0.f}, 0, 0, 0);
                u32x2 w; w.x = cvt_pk_bf16(x[0], x[1]); w.y = cvt_pk_bf16(x[2], x[3]);
                *(LAS u32x2*)(XT + (jt2 * 16 + fr) * 40 + it2 * 16 + fq * 4) = w;
            }
            __syncthreads();
            if (wv < 4) {
                const bf16x8 ta = *(const LAS bf16x8*)(TM + (32 + it2 * 16 + fr) * 72 + 32 + fq * 8);
                const bf16x8 xb = *(const LAS bf16x8*)(XT + (jt2 * 16 + fr) * 40 + fq * 8);
                const f32x4 r = __builtin_amdgcn_mfma_f32_16x16x32_bf16(ta, xb, (f32x4){0.f, 0.f, 0.f, 0.f}, 0, 0, 0);
#pragma unroll
                for (int q = 0; q < 4; ++q) TM[(32 + it2 * 16 + fq * 4 + q) * 72 + jt2 * 16 + fr] = (bf16_t)(cvt_pk_bf16(-r[q], 0.f) & 0xffffu);
            }
        }
        __syncthreads();
        {
#pragma unroll
            for (int ct = 0; ct < 4; ++ct) {
                f32x4 au = (f32x4){0.f, 0.f, 0.f, 0.f}, aw = (f32x4){0.f, 0.f, 0.f, 0.f};
#pragma unroll
                for (int kk = 0; kk < 2; ++kk) {
                    const bf16x8 tf = *(const LAS bf16x8*)(TM + (ct * 16 + fr) * 72 + kk * 32 + fq * 8);
                    const bf16x8 vf = *(const LAS bf16x8*)(VBT + (wv * 16 + fr) * 72 + kk * 32 + fq * 8);
                    const bf16x8 kf = *(const LAS bf16x8*)(KBT + (wv * 16 + fr) * 72 + kk * 32 + fq * 8);
                    au = __builtin_amdgcn_mfma_f32_16x16x32_bf16(tf, vf, au, 0, 0, 0);
                    aw = __builtin_amdgcn_mfma_f32_16x16x32_bf16(kf, tf, aw, 0, 0, 0);
                }
                u32x2 w1; w1.x = cvt_pk_bf16(au[0], au[1]); w1.y = cvt_pk_bf16(au[2], au[3]);
                *(u32x2*)(uT + ((wv * 4 + ct) * 64 + lane) * 4) = w1;
                u32x2 w2; w2.x = cvt_pk_bf16(aw[0], aw[1]); w2.y = cvt_pk_bf16(aw[2], aw[3]);
                *(u32x2*)(wM + (((ct * 4 + (wv >> 1)) * 64 + ((wv & 1) * 2 + (fq >> 1)) * 16 + fr) * 8 + (fq & 1) * 4)) = w2;
            }
        }
        __syncthreads();
    }
}

struct ScanRegs { bf16x8 X[4]; bf16x8 Y[2]; bf16x8 KD[2]; u32x2 UU; float gl; };
__device__ __forceinline__ void scan_load(ScanRegs& R, const bf16_t* baseA, const bf16_t* baseB, const float* GL, int unit, int es, int ct, bool roleB, int dt, int lane) {
    const bf16_t* xb = baseA + (roleB ? 16384 : 8192);
#pragma unroll
    for (int kk = 0; kk < 4; ++kk) R.X[kk] = *(const bf16x8*)(xb + ((ct * 4 + kk) * 64 + lane) * 8);
#pragma unroll
    for (int kk = 0; kk < 2; ++kk) R.KD[kk] = *(const bf16x8*)(baseB + ((dt * 2 + kk) * 64 + lane) * 8);
#pragma unroll
    for (int kk = 0; kk < 2; ++kk) R.Y[kk] = *(const bf16x8*)(baseB + 8192 + (roleB ? ((ct * 2 + kk) * 64 + lane) * 8 : 0));
    R.UU = *(const u32x2*)(baseA + (roleB ? 0 : ((es * 4 + ct) * 64 + lane) * 4));
    R.gl = GL[unit];
}
#define LDS_BARRIER() do { asm volatile("s_waitcnt lgkmcnt(0)" ::: "memory"); __builtin_amdgcn_s_barrier(); asm volatile("" ::: "memory"); } while (0)
__device__ __forceinline__ void scan_step(const ScanRegs& cur, f32x4& sacc, LAS bf16_t* SBc, LAS bf16_t* SBn, LAS bf16_t* VN, bf16_t* Orow  , int ct, bool roleB, int dt, int fr, int fq, int hcol) {
    bf16x8 sbf[4];
#pragma unroll
    for (int kk = 0; kk < 4; ++kk) sbf[kk] = *(const LAS bf16x8*)(SBc + fr * 136 + kk * 32 + fq * 8);
    f32x4 a = (f32x4){0.f, 0.f, 0.f, 0.f};
    if (!roleB) {
#pragma unroll
        for (int kk = 0; kk < 4; ++kk) a = __builtin_amdgcn_mfma_f32_16x16x32_bf16(cur.X[kk], sbf[kk], a, 0, 0, 0);
        const float v0 = bf_lo(cur.UU.x) - a[0], v1 = bf_hi(cur.UU.x) - a[1], v2 = bf_lo(cur.UU.y) - a[2], v3 = bf_hi(cur.UU.y) - a[3];
        u32x2 w; w.x = cvt_pk_bf16(v0, v1); w.y = cvt_pk_bf16(v2, v3);
        *(LAS u32x2*)(VN + fr * 72 + ct * 16 + fq * 4) = w;
    } else {
#pragma unroll
        for (int kk = 0; kk < 4; ++kk) a = __builtin_amdgcn_mfma_f32_16x16x32_bf16(sbf[kk], cur.X[kk], a, 0, 0, 0);
    }
    LDS_BARRIER();
    bf16x8 vnf[2];
#pragma unroll
    for (int kk = 0; kk < 2; ++kk) vnf[kk] = *(const LAS bf16x8*)(VN + fr * 72 + kk * 32 + fq * 8);
    sacc = sacc * cur.gl;
#pragma unroll
    for (int kk = 0; kk < 2; ++kk) sacc = __builtin_amdgcn_mfma_f32_16x16x32_bf16(cur.KD[kk], vnf[kk], sacc, 0, 0, 0);
    { u32x2 w; w.x = cvt_pk_bf16(sacc[0], sacc[1]); w.y = cvt_pk_bf16(sacc[2], sacc[3]);
      *(LAS u32x2*)(SBn + fr * 136 + dt * 16 + fq * 4) = w; }
    if (roleB) {
#pragma unroll
        for (int kk = 0; kk < 2; ++kk) a = __builtin_amdgcn_mfma_f32_16x16x32_bf16(vnf[kk], cur.Y[kk], a, 0, 0, 0);
        u32x2 w; w.x = cvt_pk_bf16(a[0], a[1]); w.y = cvt_pk_bf16(a[2], a[3]);
        *(u32x2*)(Orow + (size_t)(ct * 16 + fr) * 1024 + hcol + fq * 4) = w;
    }
    LDS_BARRIER();
}
__device__ __forceinline__ void scan_run(const Params& p, LAS unsigned char* lds, int wv, int lane, f32x4& sacc, int n_lo, int n_hi, bool init) {
    unsigned char* ws = p.ws;
    const int tid = threadIdx.x, fr = lane & 15, fq = lane >> 4;
    const int xcd_ = blockIdx.x & 7, j_ = blockIdx.x >> 3, bh_ = xcd_ * 2 + (j_ >> 3);
    const int b = bh_ >> 3, h = bh_ & 7, es = j_ & 7, e0 = es * 16;
    const int ct = wv & 3, dt = wv; const bool roleB = wv >= 4;
    LAS bf16_t* SB = (LAS bf16_t*)lds;
    LAS bf16_t* VN = (LAS bf16_t*)(lds + 8704);
    const bf16_t* PREPA = (const bf16_t*)p.out; const bf16_t* PREPB = (const bf16_t*)(ws + WS_PREPB); const float* GL = (const float*)(ws + WS_GL); bf16_t* O = (bf16_t*)(ws + WS_O);
    if (init) {
        for (int i = tid; i < 2 * 16 * 136 / 2; i += NTHREADS) ((LAS unsigned*)SB)[i] = 0u;
        __syncthreads();
        sacc = (f32x4){0.f, 0.f, 0.f, 0.f};
    }
    const int ubase = (b * NH + h) * NCH;
    const int hcol = h * 128 + e0;
    bf16_t* Ob = O + (size_t)(b * TB) * 1024;
#define SCAN_LOAD(R, n_) do { const int nn_ = (n_) < n_hi ? (n_) : n_hi - 1; const int unit_ = ubase + nn_; scan_load(R, PREPA + (size_t)unit_ * 24576, PREPB + (size_t)unit_ * 12288, GL, unit_, es, ct, roleB, dt, lane); } while (0)
#define SCAN_STEP(R, n_, SBr, SBw) scan_step(R, sacc, SBr, SBw, VN, Ob + (size_t)((n_) * 64) * 1024, ct, roleB, dt, fr, fq, hcol)
    ScanRegs r0, r1, r2, r3;
    SCAN_LOAD(r0, n_lo); SCAN_LOAD(r1, n_lo + 1); SCAN_LOAD(r2, n_lo + 2);
    LAS bf16_t* SB0 = SB; LAS bf16_t* SB1 = SB + 2176;
    for (int n = n_lo; n < n_hi; n += 4) {
        SCAN_LOAD(r3, n + 3); SCAN_STEP(r0, n, SB0, SB1);
        SCAN_LOAD(r0, n + 4); if (n + 1 < n_hi) SCAN_STEP(r1, n + 1, SB1, SB0);
        SCAN_LOAD(r1, n + 5); if (n + 2 < n_hi) SCAN_STEP(r2, n + 2, SB0, SB1);
        SCAN_LOAD(r2, n + 6); if (n + 3 < n_hi) SCAN_STEP(r3, n + 3, SB1, SB0);
    }
#undef SCAN_LOAD
#undef SCAN_STEP
    asm volatile("s_waitcnt vmcnt(0)" ::: "memory");
    __syncthreads();
}

__device__ __forceinline__ void phase4(const Params& p, LAS unsigned char* lds, int wv, int lane) {
    unsigned char* ws = p.ws;
    const int gw = blockIdx.x * 8 + wv, NGW = gridDim.x * 8;
    { const bf16_t* O = (const bf16_t*)(ws + WS_O); const bf16_t* Z = (const bf16_t*)(ws + WS_Z); bf16_t* OG = (bf16_t*)(ws + WS_OG);
      f32x4 nw[4];
#pragma unroll
      for (int i = 0; i < 4; ++i) nw[i] = *(const f32x4*)(p.o_norm_w + (lane & 7) * 16 + 4 * i);
      for (int rr = gw; rr < RR; rr += NGW) {
          const int prow = rr + 64 + ((rr >> 13) << 6);
          const u32x4 o0 = *(const u32x4*)(O + (size_t)prow * 1024 + lane * 16), o1 = *(const u32x4*)(O + (size_t)prow * 1024 + lane * 16 + 8);
          const u32x4 z0 = *(const u32x4*)(Z + (size_t)prow * 1024 + lane * 16), z1 = *(const u32x4*)(Z + (size_t)prow * 1024 + lane * 16 + 8);
          float ov[16], zv[16];
          ov[0] = bf_lo(o0.x); ov[1] = bf_hi(o0.x); ov[2] = bf_lo(o0.y); ov[3] = bf_hi(o0.y); ov[4] = bf_lo(o0.z); ov[5] = bf_hi(o0.z); ov[6] = bf_lo(o0.w); ov[7] = bf_hi(o0.w);
          ov[8] = bf_lo(o1.x); ov[9] = bf_hi(o1.x); ov[10] = bf_lo(o1.y); ov[11] = bf_hi(o1.y); ov[12] = bf_lo(o1.z); ov[13] = bf_hi(o1.z); ov[14] = bf_lo(o1.w); ov[15] = bf_hi(o1.w);
          zv[0] = bf_lo(z0.x); zv[1] = bf_hi(z0.x); zv[2] = bf_lo(z0.y); zv[3] = bf_hi(z0.y); zv[4] = bf_lo(z0.z); zv[5] = bf_hi(z0.z); zv[6] = bf_lo(z0.w); zv[7] = bf_hi(z0.w);
          zv[8] = bf_lo(z1.x); zv[9] = bf_hi(z1.x); zv[10] = bf_lo(z1.y); zv[11] = bf_hi(z1.y); zv[12] = bf_lo(z1.z); zv[13] = bf_hi(z1.z); zv[14] = bf_lo(z1.w); zv[15] = bf_hi(z1.w);
          float ss = 0.f;
#pragma unroll
          for (int i = 0; i < 16; ++i) ss += ov[i] * ov[i];
          ss += __shfl_xor(ss, 1); ss += __shfl_xor(ss, 2); ss += __shfl_xor(ss, 4);
          const float rstd = __builtin_amdgcn_rsqf(ss * (1.0f / 128.0f) + RMS_EPS);
          float r[16];
#pragma unroll
          for (int i = 0; i < 16; ++i) r[i] = ov[i] * rstd * nw[i >> 2][i & 3] * zv[i];
          u32x4 w0, w1; w0.x = cvt_pk_bf16(r[0], r[1]); w0.y = cvt_pk_bf16(r[2], r[3]); w0.z = cvt_pk_bf16(r[4], r[5]); w0.w = cvt_pk_bf16(r[6], r[7]);
          w1.x = cvt_pk_bf16(r[8], r[9]); w1.y = cvt_pk_bf16(r[10], r[11]); w1.z = cvt_pk_bf16(r[12], r[13]); w1.w = cvt_pk_bf16(r[14], r[15]);
          *(u32x4*)(OG + (size_t)rr * 1024 + lane * 16) = w0; *(u32x4*)(OG + (size_t)rr * 1024 + lane * 16 + 8) = w1;
      } }
    { const bf16_t* P = (const bf16_t*)(ws + WS_P); bf16_t* PO = (bf16_t*)(ws + WS_POOLED);
      const int gt = blockIdx.x * NTHREADS + threadIdx.x, NT = gridDim.x * NTHREADS;
      for (int idx = gt; idx < 4 * RR * 32; idx += NT) {
          const int cbl = idx & 31, rr = (idx >> 5) & (RR - 1), g = idx >> 19;
          const int win = 2 << g; const int prow = rr + 64 + ((rr >> 13) << 6); const int col = g * 256 + cbl * 8;
          float acc[8], self[8];
#pragma unroll
          for (int i = 0; i < 8; ++i) acc[i] = 0.f;
          for (int s = 0; s < win; ++s) { const u32x4 v = *(const u32x4*)(P + (size_t)(prow - s) * 1024 + col);
              const float f0 = bf_lo(v.x), f1 = bf_hi(v.x), f2 = bf_lo(v.y), f3 = bf_hi(v.y), f4 = bf_lo(v.z), f5 = bf_hi(v.z), f6 = bf_lo(v.w), f7 = bf_hi(v.w);
              if (s == 0) { self[0] = f0; self[1] = f1; self[2] = f2; self[3] = f3; self[4] = f4; self[5] = f5; self[6] = f6; self[7] = f7; }
              acc[0] += f0; acc[1] += f1; acc[2] += f2; acc[3] += f3; acc[4] += f4; acc[5] += f5; acc[6] += f6; acc[7] += f7; }
          const float inv = 1.0f / (float)win;
          u32x4 w; w.x = cvt_pk_bf16(acc[0] * inv - self[0], acc[1] * inv - self[1]); w.y = cvt_pk_bf16(acc[2] * inv - self[2], acc[3] * inv - self[3]);
          w.z = cvt_pk_bf16(acc[4] * inv - self[4], acc[5] * inv - self[5]); w.w = cvt_pk_bf16(acc[6] * inv - self[6], acc[7] * inv - self[7]);
          *(u32x4*)(PO + (size_t)rr * 1024 + col) = w;
      } }
}

__device__ __forceinline__ void final_phase(const Params& p, int wv, int lane) {
    const int gw = blockIdx.x * 8 + wv, NGW = gridDim.x * 8;
    const bf16_t* H2B = (const bf16_t*)(p.ws + WS_H2B);
    for (int rr = gw; rr < RR; rr += NGW) {
        const u32x4* hr = (const u32x4*)(H2B + (size_t)rr * D) + lane;
        u32x4 h[4]; float s = 0.f;
#pragma unroll
        for (int j = 0; j < 4; ++j) { h[j] = hr[64 * j];
            const float f0 = bf_lo(h[j].x), f1 = bf_hi(h[j].x), f2 = bf_lo(h[j].y), f3 = bf_hi(h[j].y), f4 = bf_lo(h[j].z), f5 = bf_hi(h[j].z), f6 = bf_lo(h[j].w), f7 = bf_hi(h[j].w);
            s += ((f0 * f0 + f1 * f1) + (f2 * f2 + f3 * f3)) + ((f4 * f4 + f5 * f5) + (f6 * f6 + f7 * f7)); }
        const float rstd = __builtin_amdgcn_rsqf(wave_sum(s) * (1.0f / D) + RMS_EPS);
#pragma unroll
        for (int j = 0; j < 4; ++j) { const int e = 8 * (lane + 64 * j); const f32x4 w0 = *(const f32x4*)(p.norm_final_w + e), w1 = *(const f32x4*)(p.norm_final_w + e + 4);
            f32x4 o0, o1; o0[0] = bf_lo(h[j].x) * rstd * w0[0]; o0[1] = bf_hi(h[j].x) * rstd * w0[1]; o0[2] = bf_lo(h[j].y) * rstd * w0[2]; o0[3] = bf_hi(h[j].y) * rstd * w0[3];
            o1[0] = bf_lo(h[j].z) * rstd * w1[0]; o1[1] = bf_hi(h[j].z) * rstd * w1[1]; o1[2] = bf_lo(h[j].w) * rstd * w1[2]; o1[3] = bf_hi(h[j].w) * rstd * w1[3];
            *(f32x4*)(p.out + (size_t)rr * D + e) = o0; *(f32x4*)(p.out + (size_t)rr * D + e + 4) = o1; }
    }
}

#define XB_TMO      128
#define XB_XCNT(j)  (256  + 64 * (j))
#define XB_XSUB(j)  (1280 + 64 * (j))
#define XB_XGEN(j)  (2304 + 64 * (j))
#define XB_TOP      3328
#define XB_TOPGEN   3392
#define XCD_BAR_WORDS 3456
#define XB_SPIN_CAP (1u << 22)
__device__ __forceinline__ unsigned xb_ld(unsigned* p)              { return __hip_atomic_load(p, __ATOMIC_RELAXED, __HIP_MEMORY_SCOPE_AGENT); }
__device__ __forceinline__ unsigned xb_add(unsigned* p, unsigned v) { return __hip_atomic_fetch_add(p, v, __ATOMIC_RELAXED, __HIP_MEMORY_SCOPE_AGENT); }
__device__ __forceinline__ unsigned xb_xcc_id() { return (unsigned)__builtin_amdgcn_s_getreg((3 << 11) | 20) & 0xFu; }
#define XB_SPIN(cond, bar) do { unsigned _sp = 0; while (cond) { __builtin_amdgcn_s_sleep(1); \
    if ((++_sp & 255u) == 0u) { if (xb_ld(&(bar)[XB_TMO])) break; if (_sp > XB_SPIN_CAP) { atomicAdd(&(bar)[XB_TMO], 1u); break; } } } } while (0)
struct XcdBarrier { unsigned* bar; unsigned x; volatile LAS unsigned* st; };
__device__ __forceinline__ XcdBarrier xcd_barrier_post(unsigned* bar, volatile LAS unsigned* st) {
    XcdBarrier b; b.bar = bar; b.x = xb_xcc_id(); b.st = st;
    if (threadIdx.x == 0) (void)xb_add(&bar[XB_XCNT(b.x)], 1u);
    return b;
}
__device__ __forceinline__ void xcd_barrier_complete(unsigned* bar, unsigned x, unsigned& nloc, unsigned& nx) {
    const unsigned G = gridDim.x * gridDim.y * gridDim.z;
    unsigned sum, cnt, mine, sp = 0u;
    for (;;) {
        sum = 0u; cnt = 0u; mine = 0u;
#pragma unroll
        for (unsigned j = 0; j < 16; ++j) { const unsigned c = xb_ld(&bar[XB_XCNT(j)]); sum += c; cnt += (c > 0u) ? 1u : 0u; mine = (j == x) ? c : mine; }
        if (sum == G) break;
        __builtin_amdgcn_s_sleep(1);
        if ((++sp & 255u) == 0u) { if (xb_ld(&bar[XB_TMO])) break; if (sp > XB_SPIN_CAP) { atomicAdd(&bar[XB_TMO], 1u); break; } }
    }
    nloc = mine > 0u ? mine : 1u; nx = cnt > 0u ? cnt : 1u;
}
__device__ __forceinline__ void xcd_barrier(const XcdBarrier& b) {
    asm volatile("s_waitcnt vmcnt(0)" ::: "memory");
    __syncthreads();
    if (threadIdx.x == 0) {
        unsigned* bar = b.bar;
        __builtin_amdgcn_s_waitcnt(0);
        unsigned nloc = b.st[0], nx = b.st[1];
        if (nloc == 0u) { xcd_barrier_complete(bar, b.x, nloc, nx); b.st[0] = nloc; b.st[1] = nx; }
        const unsigned old = xb_add(&bar[XB_XSUB(b.x)], 1u);
        const unsigned gen = old / nloc;
        if (old + 1u == (gen + 1u) * nloc) {
            __builtin_amdgcn_fence(__ATOMIC_RELEASE, "agent");
            asm volatile("s_waitcnt vmcnt(0)" ::: "memory");
            const unsigned og = xb_add(&bar[XB_TOP], 1u);
            const unsigned tg = og / nx;
            if (og + 1u == (tg + 1u) * nx) xb_add(&bar[XB_TOPGEN], 1u);
            else XB_SPIN(xb_ld(&bar[XB_TOPGEN]) == tg, bar);
            __builtin_amdgcn_fence(__ATOMIC_ACQUIRE, "agent");
            xb_add(&bar[XB_XGEN(b.x)], 1u);
            asm volatile("s_waitcnt vmcnt(0)" ::: "memory");
        } else {
            XB_SPIN(xb_ld(&bar[XB_XGEN(b.x)]) == gen, bar);
            __builtin_amdgcn_fence(__ATOMIC_ACQUIRE, "agent");
            asm volatile("s_waitcnt vmcnt(0)" ::: "memory");
        }
    }
    __syncthreads();
}

__global__ void __launch_bounds__(NTHREADS, 2) fwd_kernel(Params p) {
    extern __shared__ __attribute__((aligned(16))) unsigned char lds_raw[];
    LAS unsigned char* lds = (LAS unsigned char*)lds_raw;
    const int tid = threadIdx.x, wv = __builtin_amdgcn_readfirstlane(tid >> 6), lane = tid & 63;
    unsigned char* ws = p.ws;
    const int lo = (int)p.phase_lo, hi = (int)p.phase_hi;
#ifndef PH_MASK
#define PH_MASK 0x7ff
#endif
#define IN(k) (((PH_MASK >> (k)) & 1) && lo <= (k) && (k) < hi)
#if MK_MULTI
#define SYNC(k) do { } while (0)
#else
    cg::grid_group grid = cg::this_grid();
    volatile LAS unsigned* MISC = (volatile LAS unsigned*)(lds + LDS_BYTES - 256);
    if (tid < 32) MISC[tid] = 0u;
    __syncthreads();
    const XcdBarrier xbar = xcd_barrier_post((unsigned*)ws, MISC + 8);
#define SYNC(k) do { xcd_barrier(xbar); } while (0)
    if (hi > 1000) grid.sync();
#endif
#ifndef REP_MASK
#define REP_MASK 0
#endif
#define NREP(k) (((REP_MASK >> (k)) & 1) ? 2 : 1)
    const int G = gridDim.x, c = blockIdx.x;
    if (IN(0)) for (int rep = 0; rep < NREP(0); ++rep) { phase0(p, lds, wv, lane); SYNC(0); }
    if (IN(1)) for (int rep = 0; rep < NREP(1); ++rep) {
        pg8::Gemm g{(const bf16_t*)(ws + WS_HN), (const bf16_t*)(ws + WS_WIN), 2048, 2048, 2048, 0}; pg8::StaticOrder S; S.init(RP, NIN, G, c);
        pg8::EpiIn E{(bf16_t*)(ws + WS_QKV), (bf16_t*)(ws + WS_Z), (bf16_t*)(ws + WS_P), (unsigned char*)(ws + WS_GAB), (float*)(ws + WS_BA)};
        pg8::gemm_phase(lds, g, S, E);
        const int wc_ = (G == 256) ? ((c >= (65 * 37) % 256 && c < (65 * 37) % 256 + 32) ? c - (65 * 37) % 256 : -1) : c;
        if (wc_ >= 0) {
            pg8::Gemm g2{(const bf16_t*)(ws + WS_WB), (const bf16_t*)(ws + WS_POOLT), 1024, 256, 256, 256}; pg8::StaticOrder S; S.init(2048, 1024, G, wc_);
            pg8::EpiPlain E2{(bf16_t*)(ws + WS_WEFF), 1024};
            pg8::gemm_phase(lds, g2, S, E2); }
        { constexpr int NFULL = (65 * 37) % 256; if (G == 256 && c >= NFULL) convert_weights<true>(p, lds, wv, lane, NFULL, 256 - NFULL); else if (G != 256) convert_weights<true>(p, lds, wv, lane, 0, G); }
        SYNC(1); }
    if (IN(2) && IN(3)) {
        f32x4 sacc = (f32x4){0.f, 0.f, 0.f, 0.f};
        const bool split = (G == 256);
        const int nst = split ? 4 : 2;
        for (int st = 0; st < nst; ++st) {
            int plo, phi, slo, shi;
            if (split) { plo = st == 0 ? 0 : (st == 1 ? 96 : (st == 2 ? 128 : NCH)); phi = st == 0 ? 96 : (st == 1 ? 128 : NCH);
                         slo = st <= 1 ? 0 : (st == 2 ? 96 : 128); shi = st == 0 ? 0 : (st == 1 ? 96 : (st == 2 ? 128 : NCH)); }
            else { plo = st == 0 ? 0 : NCH; phi = NCH; slo = 0; shi = st == 0 ? 0 : NCH; }
            const bool scanner = (c < 128) && (st > 0);
            const bool all_prep = !split || st == 0;
            if (scanner) { if (slo < shi) scan_run(p, lds, wv, lane, sacc, slo, shi, slo == 0); }
            else if (plo < phi) prep_phase(p, lds, wv, lane, plo, phi, all_prep ? c : c - 128, all_prep ? G : 128);
            SYNC(2);
        }
    }
    if (IN(4)) for (int rep = 0; rep < NREP(4); ++rep) { phase4(p, lds, wv, lane); SYNC(4); }
    if (IN(6)) for (int rep = 0; rep < NREP(6); ++rep) {
        pg8::StaticOrder S; S.init(RR, 2048, G, c);
        { pg8::Gemm g{(const bf16_t*)(ws + WS_OG), (const bf16_t*)(ws + WS_WA), 1024, 1024, 1024, 0};
          pg8::EpiMerge<false> E{(const unsigned char*)(ws + WS_GAB), (bf16_t*)(ws + WS_MERGED)}; pg8::gemm_phase(lds, g, S, E); }
        { pg8::Gemm g{(const bf16_t*)(ws + WS_POOLED), (const bf16_t*)(ws + WS_WEFF), 1024, 1024, 1024, 0};
          pg8::EpiMerge<true> E{(const unsigned char*)(ws + WS_GAB), (bf16_t*)(ws + WS_MERGED)}; pg8::gemm_phase(lds, g, S, E); }
        SYNC(6); }
    if (IN(7)) for (int rep = 0; rep < NREP(7); ++rep) {
        pg8::Gemm g{(const bf16_t*)(ws + WS_MERGED), (const bf16_t*)(ws + WS_WOUT), 2048, 2048, 2048, 0}; pg8::StaticOrder S; S.init(RR, 2048, G, c);
        pg8::EpiOut E{p.x, (bf16_t*)(ws + WS_H1B), (float*)(ws + WS_SS1)};
        pg8::gemm_phase(lds, g, S, E); SYNC(7); }
    if (IN(8)) for (int rep = 0; rep < NREP(8); ++rep) {
        pg8::Gemm g{(const bf16_t*)(ws + WS_H1B), (const bf16_t*)(ws + WS_WGU), 2048, 2048, 2048, 0}; pg8::StaticOrder S; S.init(RR, 2 * FFN, G, c);
        pg8::Unit u0; const bool has0 = S.next(0, u0); const int pm0 = has0 ? u0.pm : -1;
        LAS float* RS = (LAS float*)(lds + 135168);
        if (has0 && tid < 256) { const f32x4* sp = (const f32x4*)((const float*)(ws + WS_SS1) + (size_t)(pm0 * 256 + tid) * 32); float ss = 0.f;
#pragma unroll
            for (int i = 0; i < 8; ++i) { const f32x4 q = sp[i]; ss += (q[0] + q[1]) + (q[2] + q[3]); }
            RS[tid] = __builtin_amdgcn_rsqf(ss * (1.0f / 2048.0f) + RMS_EPS); }
        __syncthreads();
        pg8::EpiGU E{(const float*)(ws + WS_SS1), (bf16_t*)(ws + WS_HIDDEN), RS, pm0};
        pg8::gemm_phase(lds, g, S, E); SYNC(8); }
    if (IN(9)) {
        pg8::Gemm g{(const bf16_t*)(ws + WS_HIDDEN), (const bf16_t*)(ws + WS_WD), FFN, FFN, FFN, 0}; pg8::StaticOrder S; S.init(RR, 2048, G, c);
        pg8::EpiDown E{(const bf16_t*)(ws + WS_H1B), (bf16_t*)(ws + WS_H2B)};
        pg8::gemm_phase(lds, g, S, E); SYNC(9); }
    if (IN(10)) final_phase(p, wv, lane);
#ifdef DIGEST_OFF
    if (lo <= 11 && 11 < hi) {
        const bf16_t* src = (const bf16_t*)(ws + (size_t)DIGEST_OFF * MiB);
        for (size_t i = (size_t)blockIdx.x * NTHREADS + tid; i < (size_t)RR * D; i += (size_t)gridDim.x * NTHREADS)
            p.out[i] = __uint_as_float((unsigned)src[(i * DIGEST_STRIDE) % (size_t)DIGEST_N] << 16);
    }
#endif
#undef IN
#undef SYNC
}

extern "C" void kernel_launch(void* const* d_in, const int* in_sizes, int n_in, void* d_out, int out_size, void* d_ws, size_t ws_size, hipStream_t stream) {
    static int grid = 0;
    if (grid == 0) {
        if (n_in != 18 || ws_size < WS_END) { fprintf(stderr, "kernel_launch: unexpected n_in %d or ws_size %zu\n", n_in, ws_size); grid = -1; return; }
        int dev = 0, cus = 0, per_cu = 0;
        hipGetDevice(&dev); hipDeviceGetAttribute(&cus, hipDeviceAttributeMultiprocessorCount, dev);
        if (hipFuncSetAttribute((const void*)fwd_kernel, hipFuncAttributeMaxDynamicSharedMemorySize, LDS_BYTES) != hipSuccess) { fprintf(stderr, "kernel_launch: hipFuncSetAttribute failed\n"); grid = -1; return; }
        hipOccupancyMaxActiveBlocksPerMultiprocessor(&per_cu, (const void*)fwd_kernel, NTHREADS, LDS_BYTES);
        (void)hipGetLastError();
        if (per_cu < 1) { fprintf(stderr, "kernel_launch: occupancy query says %d blocks per CU\n", per_cu); }
        grid = cus;
    }
    if (grid < 0) return;
    Params p{};
    p.x = (const float*)d_in[0]; p.meta = (const float*)d_in[1]; p.norm_mix_w = (const float*)d_in[2]; p.w_in = (const float*)d_in[3]; p.conv_w = (const float*)d_in[4];
    p.a_log = (const float*)d_in[5]; p.dt_bias = (const float*)d_in[6]; p.o_norm_w = (const float*)d_in[7]; p.w_proj_a = (const float*)d_in[8]; p.pool_w = (const float*)d_in[9];
    p.pool_scale = (const float*)d_in[10]; p.w_proj_b = (const float*)d_in[11]; p.w_out = (const float*)d_in[12]; p.norm_ffn_w = (const float*)d_in[13]; p.w_gate = (const float*)d_in[14];
    p.w_up = (const float*)d_in[15]; p.w_down = (const float*)d_in[16]; p.norm_final_w = (const float*)d_in[17];
    p.out = (float*)d_out; p.ws = (unsigned char*)d_ws;
#if MK_MULTI
    for (int ph = 0; ph <= 11; ++ph) { p.phase_lo = ph; p.phase_hi = ph + 1; hipLaunchKernelGGL(fwd_kernel, dim3(grid), dim3(NTHREADS), LDS_BYTES, stream, p); }
#else
    p.phase_lo = 0; p.phase_hi = 12;
    if (hipMemsetAsync(d_ws, 0, 16384, stream) != hipSuccess) { fprintf(stderr, "kernel_launch: memset of the barrier words failed\n"); return; }
    void* args[] = {&p};
    hipError_t e = hipLaunchCooperativeKernel((const void*)fwd_kernel, dim3(grid), dim3(NTHREADS), args, LDS_BYTES, stream);
    if (e != hipSuccess) fprintf(stderr, "cooperative launch failed: %s (grid %d)\n", hipGetErrorString(e), grid);
#endif
}
```

```cpp
#include <hip/hip_runtime.h>
#include <hip/hip_cooperative_groups.h>
#include <cstdio>
#include <cstdint>
namespace cg = cooperative_groups;

#define LAS __attribute__((address_space(3)))
typedef unsigned short bf16_t;
typedef short bf16x8 __attribute__((ext_vector_type(8)));
typedef float f32x4 __attribute__((ext_vector_type(4)));
typedef float f32x2 __attribute__((ext_vector_type(2)));
typedef unsigned u32x4 __attribute__((ext_vector_type(4)));
typedef unsigned u32x2 __attribute__((ext_vector_type(2)));

#ifndef MK_MULTI
#define MK_MULTI 0
#endif

constexpr int D = 2048, SEQ = 8192, NMETA = 16, TB = 8256  , RPV = 2 * TB  , RP = 16640  , RR = 16384;
constexpr int NCH = 129, NH = 8, HD = 128, NUNIT = 2 * NCH * NH  , UNIT_EL = 36864;
constexpr int FFN = 5632, NIN = 9472;
constexpr float RMS_EPS = 1e-6f, L2_EPS = 1e-6f;
constexpr int NTHREADS = 512;
constexpr int LDS_BYTES = 147456;

constexpr size_t MiB = 1u << 20;
constexpr size_t WS_BA = 1 * MiB, WS_GL = 2 * MiB + 512 * 1024, WS_SS1 = 3 * MiB;
constexpr size_t WS_WIN = 8 * MiB, WS_WA = 45 * MiB, WS_WB = 49 * MiB, WS_POOLT = 53 * MiB;
constexpr size_t WS_WOUT = 54 * MiB, WS_WGU = 62 * MiB, WS_WD = 106 * MiB;
constexpr size_t WS_PREPB = 128 * MiB;
constexpr size_t WS_HN = 128 * MiB, WS_QKV = 200 * MiB, WS_Z = 298 * MiB, WS_P = 331 * MiB, WS_GAB = 364 * MiB;
constexpr size_t WS_O = 200 * MiB, WS_OG = 233 * MiB, WS_POOLED = 266 * MiB, WS_ZB = 128 * MiB, WS_MERGED = 160 * MiB, WS_H1B = 364 * MiB, WS_HIDDEN = 128 * MiB;
constexpr size_t WS_H2B = 428 * MiB;
constexpr size_t WS_WEFF = 494 * MiB;
constexpr size_t WS_END = 498 * MiB;
static_assert(WS_PREPB + (size_t)NUNIT * 12288 * 2 <= WS_QKV && (size_t)NUNIT * 24576 * 2 <= (size_t)RR * D * 4, "prep records");
static_assert(WS_GAB + (size_t)RP * 4096 * 2 <= WS_END, "gab");
static_assert(WS_HIDDEN + (size_t)RR * FFN * 2 <= WS_H1B, "hidden");

struct Params {
    const float* x; const float* meta; const float* norm_mix_w; const float* w_in; const float* conv_w; const float* a_log; const float* dt_bias; const float* o_norm_w;
    const float* w_proj_a; const float* pool_w; const float* pool_scale; const float* w_proj_b; const float* w_out; const float* norm_ffn_w; const float* w_gate; const float* w_up;
    const float* w_down; const float* norm_final_w;
    float* out; unsigned char* ws;
    long long phase_lo, phase_hi;
};

typedef __bf16 bf16x2_t __attribute__((ext_vector_type(2)));
__device__ __forceinline__ unsigned cvt_pk_bf16(float lo, float hi) { const f32x2 v = {lo, hi}; const bf16x2_t b = __builtin_convertvector(v, bf16x2_t); return __builtin_bit_cast(unsigned, b); }
__device__ __forceinline__ float bf_lo(unsigned w) { return __uint_as_float(w << 16); }
__device__ __forceinline__ float bf_hi(unsigned w) { return __uint_as_float(w & 0xffff0000u); }
__device__ __forceinline__ float fast_sigmoid(float x) { return __builtin_amdgcn_rcpf(1.0f + __expf(-x)); }
__device__ __forceinline__ float fast_silu(float x) { return x * fast_sigmoid(x); }
__device__ __forceinline__ float wave_sum(float v) {
#pragma unroll
    for (int o = 1; o < 64; o <<= 1) v += __shfl_xor(v, o);
    return v;
}
#define LDS_WAIT() asm volatile("s_waitcnt lgkmcnt(0)" ::: "memory")

namespace pg8 {
constexpr int BM = 256, BK = 64, HALF = 128, HTB = HALF * BK * 2, STAGE_BYTES = 8 * HTB, NXCD = 8, WGM = 8;
__host__ __device__ __forceinline__ int lds_byte(int r, int c) { const int st = (r >> 4) * 2 + (c >> 5), rr = r & 15, cc = c & 31, ob = rr * 64 + cc * 2; return st * 1024 + (ob ^ (((ob >> 9) & 1) << 5)); }
__host__ __device__ __forceinline__ void stage_rc(int b, int& R, int& C) { const int st = b / 1024, sb = b % 1024, swz = sb ^ (((sb >> 9) & 1) << 5); R = (st >> 1) * 16 + swz / 64; C = (st & 1) * 32 + (swz % 64) / 2; }
__host__ __device__ __forceinline__ int perm32(int rho) { const int n = rho >> 4, i = rho & 15; return 8 * (i >> 2) + 4 * n + (i & 3); }

struct Unit { int pm, pn; };
struct Gemm { const bf16_t* A; const bf16_t* Bt; int lda, ldb, K, a_pn_off; };

struct StaticOrder {
    int nM, nN, nwg, G, c;
    __device__ void init(int M, int N, int G_, int c_) { nM = M / BM; nN = N / BM; nwg = nM * nN; G = G_; c = c_; }
    __device__ bool next(int i, Unit& u) const {
        const long L = (long)i * G + c; if (L >= nwg) return false;
        int wgid = (int)L; { const int q = nwg / NXCD, r = nwg % NXCD, xcd = wgid % NXCD, off = wgid / NXCD; wgid = (xcd < r ? xcd * (q + 1) : r * (q + 1) + (xcd - r) * q) + off; }
        const int nig = WGM * nN, gid = wgid / nig, fm = gid * WGM, gsz = (nM - fm) < WGM ? (nM - fm) : WGM;
        u.pm = fm + ((wgid % nig) % gsz); u.pn = (wgid % nig) / gsz; return true;
    }
};

template <class Epi>
__device__ __forceinline__ void gemm_phase(LAS unsigned char* lds, const Gemm g, const StaticOrder& S, const Epi& E) {
    const int tid = threadIdx.x, wid = __builtin_amdgcn_readfirstlane(tid >> 6), lane = tid & 63, wr = wid >> 2, wc = wid & 3, fr = lane & 15, fq = lane >> 4;
    const int nt = g.K / BK;
    unsigned voffA[2], voffB[2];
#pragma unroll
    for (int i = 0; i < 2; ++i) { int R, C; stage_rc(tid * 16 + i * 8192, R, C); const int Rb = (R & ~31) + perm32(R & 31);
        voffA[i] = (unsigned)(R * g.lda + C) * 2u; voffB[i] = (unsigned)(Rb * g.ldb + C) * 2u; }
    const size_t kstep = (size_t)(BK * 2);
    const size_t hstepA = (size_t)HALF * g.lda * 2, hstepB = (size_t)HALF * g.ldb * 2;
    const unsigned ldsw = (unsigned)wid * 1024u;
    const int aoff = lds_byte(wr * 64 + fr, fq * 8), boff = lds_byte(wc * 32 + fr, fq * 8);
#define PG8_SA(b, h) (((b) * 2 + (h)) * HTB)
#define PG8_SB(b, h) ((4 + (b) * 2 + (h)) * HTB)
#define PG8_STAGE(bufoff, gbase, voff) do { _Pragma("unroll") for (int _i = 0; _i < 2; ++_i) \
        __builtin_amdgcn_global_load_lds((const unsigned*)((const char*)(gbase) + (voff)[_i]), (LAS unsigned*)(lds + (bufoff) + ldsw + _i * 8192), 16, 0, 0); } while (0)
#define PG8_LDA(dst, b, h) do { _Pragma("unroll") for (int m = 0; m < 4; ++m) _Pragma("unroll") for (int k = 0; k < 2; ++k) dst[m][k] = *(const LAS bf16x8*)(lds + PG8_SA(b, h) + aoff + m * 2048 + k * 1024); } while (0)
#define PG8_LDB(dst, b, h) do { _Pragma("unroll") for (int n = 0; n < 2; ++n) _Pragma("unroll") for (int k = 0; k < 2; ++k) dst[n][k] = *(const LAS bf16x8*)(lds + PG8_SB(b, h) + boff + n * 2048 + k * 1024); } while (0)
#define PG8_MMA(ai, bj, At, Bt) do { __builtin_amdgcn_s_setprio(1); _Pragma("unroll") for (int m = 0; m < 4; ++m) _Pragma("unroll") for (int n = 0; n < 2; ++n) _Pragma("unroll") for (int k = 0; k < 2; ++k) \
        acc[ai][bj][m][n] = __builtin_amdgcn_mfma_f32_16x16x32_bf16(Bt[n][k], At[m][k], acc[ai][bj][m][n], 0, 0, 0); __builtin_amdgcn_s_setprio(0); } while (0)
#define PG8_WAIT_V(n) asm volatile("s_waitcnt vmcnt(" #n ")" ::: "memory")
#define PG8_WAIT_L(n) asm volatile("s_waitcnt lgkmcnt(" #n ")" ::: "memory")
#define PG8_BAR __builtin_amdgcn_s_barrier()
#define PG8_SCHED __builtin_amdgcn_sched_barrier(0)
    Unit cur, nxt; int ui = 0;
    if (!S.next(0, cur)) return;
    f32x4 acc[2][2][4][2];
#pragma unroll
    for (int a = 0; a < 2; ++a)
#pragma unroll
        for (int b = 0; b < 2; ++b)
#pragma unroll
            for (int m = 0; m < 4; ++m)
#pragma unroll
                for (int n = 0; n < 2; ++n) acc[a][b][m][n] = (f32x4){0.f, 0.f, 0.f, 0.f};
    bf16x8 At[4][2], B0[2][2], B1[2][2];
    const char* cA = (const char*)g.A + (size_t)cur.pm * 2 * hstepA + (size_t)cur.pn * g.a_pn_off * 2; const char* cB = (const char*)g.Bt + (size_t)cur.pn * 2 * hstepB;
    PG8_STAGE(PG8_SB(0, 0), cB, voffB); PG8_STAGE(PG8_SB(0, 1), cB + hstepB, voffB); PG8_STAGE(PG8_SA(0, 0), cA, voffA); PG8_STAGE(PG8_SA(0, 1), cA + hstepA, voffA);
    if (wr == 1) PG8_BAR;
    PG8_WAIT_V(2); PG8_BAR;
    PG8_STAGE(PG8_SB(1, 0), cB + kstep, voffB); PG8_STAGE(PG8_SA(1, 0), cA + kstep, voffA); PG8_STAGE(PG8_SB(1, 1), cB + hstepB + kstep, voffB);
    PG8_WAIT_V(6); PG8_BAR;
    for (;;) {
        const bool has_next = S.next(ui + 1, nxt);
        const char* nA = has_next ? (const char*)g.A + (size_t)nxt.pm * 2 * hstepA + (size_t)nxt.pn * g.a_pn_off * 2 : cA; const char* nB = has_next ? (const char*)g.Bt + (size_t)nxt.pn * 2 * hstepB : cB;
#pragma unroll 1
        for (int t = 0; t < nt; t += 2) {
            const bool last = (t == nt - 2);
            const char* a1 = cA + (size_t)(t + 1) * kstep;
            const char* a2 = last ? nA : cA + (size_t)(t + 2) * kstep; const char* b2 = last ? nB : cB + (size_t)(t + 2) * kstep;
            const char* a3 = a2 + kstep; const char* b3 = b2 + kstep;
            PG8_LDB(B0, 0, 0); PG8_LDB(B1, 0, 1); PG8_SCHED; PG8_LDA(At, 0, 0); PG8_STAGE(PG8_SA(1, 1), a1 + hstepA, voffA);
            PG8_WAIT_V(8); PG8_WAIT_L(0); PG8_BAR; PG8_MMA(0, 0, At, B0); PG8_MMA(0, 1, At, B1); PG8_BAR; PG8_SCHED;
            PG8_LDA(At, 0, 1); PG8_STAGE(PG8_SB(0, 0), b2, voffB); PG8_STAGE(PG8_SB(0, 1), b2 + hstepB, voffB); PG8_STAGE(PG8_SA(0, 0), a2, voffA);
            PG8_WAIT_V(8); PG8_WAIT_L(0); PG8_BAR; PG8_MMA(1, 0, At, B0); PG8_MMA(1, 1, At, B1); PG8_BAR; PG8_SCHED;
            PG8_LDB(B0, 1, 0); PG8_LDB(B1, 1, 1); PG8_SCHED; PG8_LDA(At, 1, 0); PG8_STAGE(PG8_SA(0, 1), a2 + hstepA, voffA);
            PG8_WAIT_V(8); PG8_WAIT_L(0); PG8_BAR; PG8_MMA(0, 0, At, B0); PG8_MMA(0, 1, At, B1); PG8_BAR; PG8_SCHED;
            PG8_LDA(At, 1, 1); PG8_STAGE(PG8_SB(1, 0), b3, voffB); PG8_STAGE(PG8_SB(1, 1), b3 + hstepB, voffB); PG8_STAGE(PG8_SA(1, 0), a3, voffA);
            PG8_WAIT_V(8); PG8_WAIT_L(0); PG8_BAR; PG8_MMA(1, 0, At, B0); PG8_MMA(1, 1, At, B1); PG8_BAR; PG8_SCHED;
        }
        if (wr == 0) PG8_BAR;
        E(acc, cur, wr, wc, fr, fq);
        if (!has_next) break;
#pragma unroll
        for (int a = 0; a < 2; ++a)
#pragma unroll
            for (int b = 0; b < 2; ++b)
#pragma unroll
                for (int m = 0; m < 4; ++m)
#pragma unroll
                    for (int n = 0; n < 2; ++n) acc[a][b][m][n] = (f32x4){0.f, 0.f, 0.f, 0.f};
        cur = nxt; cA = nA; cB = nB; ++ui;
        if (wr == 1) PG8_BAR;
    }
    PG8_WAIT_V(0);
    PG8_BAR;
#undef PG8_SA
#undef PG8_SB
#undef PG8_STAGE
#undef PG8_LDA
#undef PG8_LDB
#undef PG8_MMA
#undef PG8_WAIT_V
#undef PG8_WAIT_L
#undef PG8_BAR
#undef PG8_SCHED
}

typedef f32x4 AccT[2][2][4][2];
template <int ACT  >
__device__ __forceinline__ void store_tile_bf16(const AccT& acc, bf16_t* base  , int ld, int row0) {
#pragma unroll
    for (int ai = 0; ai < 2; ++ai)
#pragma unroll
        for (int m = 0; m < 4; ++m) { bf16_t* rowp = base + (size_t)(row0 + ai * HALF + m * 16) * ld;
#pragma unroll
            for (int bj = 0; bj < 2; ++bj) { f32x4 v0 = acc[ai][bj][m][0], v1 = acc[ai][bj][m][1];
                if (ACT == 1) { for (int i = 0; i < 4; ++i) { v0[i] = fast_silu(v0[i]); v1[i] = fast_silu(v1[i]); } }
                if (ACT == 2) { for (int i = 0; i < 4; ++i) { v0[i] = fast_sigmoid(v0[i]); v1[i] = fast_sigmoid(v1[i]); } }
                u32x4 w; w.x = cvt_pk_bf16(v0[0], v0[1]); w.y = cvt_pk_bf16(v0[2], v0[3]); w.z = cvt_pk_bf16(v1[0], v1[1]); w.w = cvt_pk_bf16(v1[2], v1[3]);
                *(u32x4*)(rowp + bj * HALF) = w; } }
}
__device__ __forceinline__ unsigned q8(float x) { return (unsigned)(fast_sigmoid(x) * 255.0f + 0.5f); }
__device__ __forceinline__ void store_tile_gate_u8(const AccT& acc, unsigned char* base  , int row0) {
#pragma unroll
    for (int ai = 0; ai < 2; ++ai)
#pragma unroll
        for (int m = 0; m < 4; ++m) { unsigned char* rowp = base + (size_t)(row0 + ai * HALF + m * 16) * 4096;
#pragma unroll
            for (int bj = 0; bj < 2; ++bj) { const f32x4 v0 = acc[ai][bj][m][0], v1 = acc[ai][bj][m][1];
                u32x2 w; w.x = q8(v0[0]) | (q8(v0[1]) << 8) | (q8(v0[2]) << 16) | (q8(v0[3]) << 24); w.y = q8(v1[0]) | (q8(v1[1]) << 8) | (q8(v1[2]) << 16) | (q8(v1[3]) << 24);
                *(u32x2*)(rowp + bj * HALF) = w; } }
}
struct EpiIn {
    bf16_t* QKV; bf16_t* Z; bf16_t* P; unsigned char* GAB; float* BA;
    __device__ __forceinline__ void operator()(const AccT& acc, const Unit& u, int wr, int wc, int fr, int fq) const {
        const int pn = u.pn, row0 = u.pm * BM + wr * 64 + fr, cl = wc * 32 + 8 * fq;
        if (pn == 36) {
            if (wc == 0 && fq < 2) {
#pragma unroll
                for (int ai = 0; ai < 2; ++ai)
#pragma unroll
                    for (int m = 0; m < 4; ++m) { float* q = BA + (size_t)(row0 + ai * HALF + m * 16) * 16 + 8 * fq; *(f32x4*)q = acc[ai][0][m][0]; *(f32x4*)(q + 4) = acc[ai][0][m][1]; }
            }
            return;
        }
        if (pn < 12) store_tile_bf16<0>(acc, QKV + pn * 256 + cl, 3072, row0);
        else if (pn < 16) store_tile_bf16<1>(acc, Z + (pn - 12) * 256 + cl, 1024, row0);
        else if (pn < 20) store_tile_bf16<0>(acc, P + (pn - 16) * 256 + cl, 1024, row0);
        else store_tile_gate_u8(acc, GAB + (pn - 20) * 256 + cl, row0);
    }
};
struct EpiPlain {
    bf16_t* O; int ld;
    __device__ __forceinline__ void operator()(const AccT& acc, const Unit& u, int wr, int wc, int fr, int fq) const {
        store_tile_bf16<0>(acc, O + u.pn * 256 + wc * 32 + 8 * fq, ld, u.pm * BM + wr * 64 + fr);
    }
};
template <bool SECOND> struct EpiMerge {
    const unsigned char* GAB; bf16_t* MERGED;
    __device__ __forceinline__ void operator()(const AccT& acc, const Unit& u, int wr, int wc, int fr, int fq) const {
        const int row0 = u.pm * BM + wr * 64 + fr, cl = u.pn * 256 + wc * 32 + 8 * fq;
#pragma unroll
        for (int ai = 0; ai < 2; ++ai)
#pragma unroll
            for (int m = 0; m < 4; ++m) { const int rr = row0 + ai * HALF + m * 16; const int prow = rr + 64 + ((rr >> 13) << 6);
                const unsigned char* gp = GAB + (size_t)prow * 4096 + (SECOND ? 2048 : 0) + cl; bf16_t* mp = MERGED + (size_t)rr * 2048 + cl;
#pragma unroll
                for (int bj = 0; bj < 2; ++bj) { const u32x2 gw = *(const u32x2*)(gp + bj * HALF); const f32x4 v0 = acc[ai][bj][m][0] * (1.0f / 255.0f), v1 = acc[ai][bj][m][1] * (1.0f / 255.0f);
                    float r0 = (float)(gw.x & 0xffu) * v0[0], r1 = (float)((gw.x >> 8) & 0xffu) * v0[1], r2 = (float)((gw.x >> 16) & 0xffu) * v0[2], r3 = (float)(gw.x >> 24) * v0[3];
                    float r4 = (float)(gw.y & 0xffu) * v1[0], r5 = (float)((gw.y >> 8) & 0xffu) * v1[1], r6 = (float)((gw.y >> 16) & 0xffu) * v1[2], r7 = (float)(gw.y >> 24) * v1[3];
                    if (SECOND) { const u32x4 mw = *(const u32x4*)(mp + bj * HALF);
                        r0 += bf_lo(mw.x); r1 += bf_hi(mw.x); r2 += bf_lo(mw.y); r3 += bf_hi(mw.y); r4 += bf_lo(mw.z); r5 += bf_hi(mw.z); r6 += bf_lo(mw.w); r7 += bf_hi(mw.w); }
                    u32x4 w; w.x = cvt_pk_bf16(r0, r1); w.y = cvt_pk_bf16(r2, r3); w.z = cvt_pk_bf16(r4, r5); w.w = cvt_pk_bf16(r6, r7);
                    *(u32x4*)(mp + bj * HALF) = w; } }
    }
};
struct EpiOut {
    const float* x; bf16_t* H1B; float* SS1;
    __device__ __forceinline__ void operator()(const AccT& acc, const Unit& u, int wr, int wc, int fr, int fq) const {
        const int row0 = u.pm * BM + wr * 64 + fr, cl = u.pn * 256 + wc * 32 + 8 * fq;
#pragma unroll
        for (int ai = 0; ai < 2; ++ai)
#pragma unroll
            for (int m = 0; m < 4; ++m) { const int rr = row0 + ai * HALF + m * 16; const size_t off = (size_t)rr * 2048 + cl; float ss = 0.f;
#pragma unroll
                for (int bj = 0; bj < 2; ++bj) { const f32x4 x0 = *(const f32x4*)(x + off + bj * HALF), x1 = *(const f32x4*)(x + off + bj * HALF + 4);
                    const f32x4 h0 = x0 + acc[ai][bj][m][0], h1 = x1 + acc[ai][bj][m][1];
                    ss += (h0[0] * h0[0] + h0[1] * h0[1]) + (h0[2] * h0[2] + h0[3] * h0[3]) + (h1[0] * h1[0] + h1[1] * h1[1]) + (h1[2] * h1[2] + h1[3] * h1[3]);
                    u32x4 w; w.x = cvt_pk_bf16(h0[0], h0[1]); w.y = cvt_pk_bf16(h0[2], h0[3]); w.z = cvt_pk_bf16(h1[0], h1[1]); w.w = cvt_pk_bf16(h1[2], h1[3]);
                    *(u32x4*)(H1B + off + bj * HALF) = w; }
                ss += __shfl_xor(ss, 16); ss += __shfl_xor(ss, 32);
                if (fq == 0) SS1[(size_t)rr * 32 + u.pn * 4 + wc] = ss; }
    }
};
struct EpiGU {
    const float* SS1; bf16_t* HID; const LAS float* RS; int pm0;
    __device__ __forceinline__ void operator()(const AccT& acc, const Unit& u, int wr, int wc, int fr, int fq) const {
        const int row0 = u.pm * BM + wr * 64 + fr, cl = u.pn * 128 + wc * 32 + 8 * fq;
#pragma unroll
        for (int ai = 0; ai < 2; ++ai)
#pragma unroll
            for (int m = 0; m < 4; ++m) { const int rr = row0 + ai * HALF + m * 16; float rstd;
                if (u.pm == pm0) rstd = RS[ai * HALF + wr * 64 + m * 16 + fr];
                else { const f32x4* sp = (const f32x4*)(SS1 + (size_t)rr * 32) + 2 * fq; float ss;
                    { const f32x4 s0 = sp[0], s1 = sp[1]; ss = ((s0[0] + s0[1]) + (s0[2] + s0[3])) + ((s1[0] + s1[1]) + (s1[2] + s1[3])); }
                    ss += __shfl_xor(ss, 16); ss += __shfl_xor(ss, 32);
                    rstd = __builtin_amdgcn_rsqf(ss * (1.0f / 2048.0f) + RMS_EPS); }
                const f32x4 g0 = acc[ai][0][m][0] * rstd, g1 = acc[ai][0][m][1] * rstd, u0 = acc[ai][1][m][0] * rstd, u1 = acc[ai][1][m][1] * rstd;
                u32x4 w; w.x = cvt_pk_bf16(fast_silu(g0[0]) * u0[0], fast_silu(g0[1]) * u0[1]); w.y = cvt_pk_bf16(fast_silu(g0[2]) * u0[2], fast_silu(g0[3]) * u0[3]);
                w.z = cvt_pk_bf16(fast_silu(g1[0]) * u1[0], fast_silu(g1[1]) * u1[1]); w.w = cvt_pk_bf16(fast_silu(g1[2]) * u1[2], fast_silu(g1[3]) * u1[3]);
                *(u32x4*)(HID + (size_t)rr * FFN + cl) = w; }
    }
};
struct EpiDown {
    const bf16_t* H1B; bf16_t* H2B;
    __device__ __forceinline__ void operator()(const AccT& acc, const Unit& u, int wr, int wc, int fr, int fq) const {
        const int row0 = u.pm * BM + wr * 64 + fr, cl = u.pn * 256 + wc * 32 + 8 * fq;
#pragma unroll
        for (int ai = 0; ai < 2; ++ai)
#pragma unroll
            for (int m = 0; m < 4; ++m) { const size_t off = (size_t)(row0 + ai * HALF + m * 16) * 2048 + cl;
#pragma unroll
                for (int bj = 0; bj < 2; ++bj) { const u32x4 hw = *(const u32x4*)(H1B + off + bj * HALF); const f32x4 v0 = acc[ai][bj][m][0], v1 = acc[ai][bj][m][1];
                    u32x4 w; w.x = cvt_pk_bf16(bf_lo(hw.x) + v0[0], bf_hi(hw.x) + v0[1]); w.y = cvt_pk_bf16(bf_lo(hw.y) + v0[2], bf_hi(hw.y) + v0[3]);
                    w.z = cvt_pk_bf16(bf_lo(hw.z) + v1[0], bf_hi(hw.z) + v1[1]); w.w = cvt_pk_bf16(bf_lo(hw.w) + v1[2], bf_hi(hw.w) + v1[3]);
                    *(u32x4*)(H2B + off + bj * HALF) = w; } }
    }
};
}

constexpr int TR_LDS = 64 * 65 * 4;
struct TrDesc { const float* src; bf16_t* dst; const float* kscale; int ldw, ncols, ldk; };
struct TrRegs { f32x4 v[16]; float ks; };
__device__ __forceinline__ void tr_load(const TrDesc& d, TrRegs& R, int lane) {
    const int r4 = lane >> 4, cq = lane & 15;
    const bool on = 4 * cq < d.ncols;
    const float* sp = d.src + (size_t)r4 * d.ldw + (on ? 4 * cq : 0);
#pragma unroll
    for (int it = 0; it < 16; ++it) { const f32x4 x = *(const f32x4*)(sp + (size_t)(4 * it) * d.ldw); R.v[it] = on ? x : (f32x4){0.f, 0.f, 0.f, 0.f}; }
    R.ks = d.kscale ? d.kscale[lane] : 1.0f;
}
__device__ __forceinline__ void tr_finish(const TrDesc& d, const TrRegs& R, LAS float* scr, int lane, bool valid) {
    const int r4 = lane >> 4, cq = lane & 15;
#pragma unroll
    for (int it = 0; it < 16; ++it) { const int kk = 4 * it + r4; const float kv = __shfl(R.ks, kk); const f32x4 v = R.v[it] * kv;
        LAS float* q = scr + kk * 65 + 4 * cq; q[0] = v[0]; q[1] = v[1]; q[2] = v[2]; q[3] = v[3]; }
    LDS_WAIT(); asm volatile("" ::: "memory");
    const int cc = lane & 7;
#pragma unroll
    for (int j = 0; j < 8; ++j) { const int n = (lane >> 3) + 8 * j; const LAS float* sp = scr + (8 * cc) * 65 + n;
        u32x4 o; o.x = cvt_pk_bf16(sp[0 * 65], sp[1 * 65]); o.y = cvt_pk_bf16(sp[2 * 65], sp[3 * 65]); o.z = cvt_pk_bf16(sp[4 * 65], sp[5 * 65]); o.w = cvt_pk_bf16(sp[6 * 65], sp[7 * 65]);
        if (valid) *(u32x4*)(d.dst + (size_t)n * d.ldk + 8 * cc) = o; }
    LDS_WAIT(); asm volatile("" ::: "memory");
}
constexpr int EARLY_ITEMS = 148 * 32 + 32 * 16 + 32 * 16;
__device__ __forceinline__ TrDesc early_desc(const Params& p, int r) {
    unsigned char* ws = p.ws; TrDesc d; d.kscale = nullptr;
    constexpr int I_IN = 148 * 32, I_A = 32 * 16;
    if (r < I_IN) { const int rb = r / 32, kb = r % 32, dst = rb * 64; int src, nc;
        if (dst < 9216) { src = dst + (dst >= 4096 ? 16 : 0); nc = 64; } else if (dst == 9216) { src = 4096; nc = 16; } else { src = 0; nc = 0; }
        d.src = p.w_in + (size_t)(kb * 64) * 9232 + src; d.ldw = 9232; d.ncols = nc; d.dst = (bf16_t*)(ws + WS_WIN) + (size_t)dst * 2048 + kb * 64; d.ldk = 2048; return d; }
    r -= I_IN;
    const bool isb = r >= I_A; if (isb) r -= I_A;
    const int rb = r / 16, kb = r % 16;
    d.src = (isb ? p.w_proj_b : p.w_proj_a) + (size_t)(kb * 64) * 2048 + rb * 64; d.ldw = 2048; d.ncols = 64; d.dst = (bf16_t*)(ws + (isb ? WS_WB : WS_WA)) + (size_t)(rb * 64) * 1024 + kb * 64; d.ldk = 1024; return d;
}
constexpr int LATE_ITEMS = 32 * 32 + 2 * 88 * 32 + 32 * 88;
__device__ __forceinline__ TrDesc late_desc(const Params& p, int r) {
    unsigned char* ws = p.ws; TrDesc d; d.kscale = nullptr;
    constexpr int I_O = 32 * 32, I_G = 88 * 32;
    if (r < I_O) { const int rb = r / 32, kb = r % 32; d.src = p.w_out + (size_t)(kb * 64) * 2048 + rb * 64; d.ldw = 2048; d.ncols = 64; d.dst = (bf16_t*)(ws + WS_WOUT) + (size_t)(rb * 64) * 2048 + kb * 64; d.ldk = 2048; return d; }
    r -= I_O;
    if (r < 2 * I_G) { const bool up = r >= I_G; if (up) r -= I_G; const int rb = r / 32, kb = r % 32, j0 = rb * 64; const int dst = (j0 / 128) * 256 + (j0 % 128) + (up ? 128 : 0);
        d.src = (up ? p.w_up : p.w_gate) + (size_t)(kb * 64) * FFN + j0; d.ldw = FFN; d.ncols = 64; d.dst = (bf16_t*)(ws + WS_WGU) + (size_t)dst * 2048 + kb * 64; d.ldk = 2048; d.kscale = p.norm_ffn_w + kb * 64; return d; }
    r -= 2 * I_G;
    { const int rb = r / 88, kb = r % 88; d.src = p.w_down + (size_t)(kb * 64) * 2048 + rb * 64; d.ldw = 2048; d.ncols = 64; d.dst = (bf16_t*)(ws + WS_WD) + (size_t)(rb * 64) * FFN + kb * 64; d.ldk = FFN; return d; }
}
template <bool LATE>
__device__ __forceinline__ void convert_weights(const Params& p, LAS unsigned char* lds, int wv, int lane, int wg0, int nwg) {
    LAS float* scr = (LAS float*)(lds + wv * TR_LDS);
    const int gw = ((int)blockIdx.x - wg0) * 8 + wv, NGW = nwg * 8;
    constexpr int NI = LATE ? LATE_ITEMS : EARLY_ITEMS;
    const int trips = (NI + NGW - 1) / NGW;
#define TR_DESC(i_) (LATE ? late_desc(p, (i_) < NI ? (i_) : NI - 1) : early_desc(p, (i_) < NI ? (i_) : NI - 1))
    TrDesc d0 = TR_DESC(gw), d1 = TR_DESC(gw + NGW);
    TrRegs r0, r1;
    tr_load(d0, r0, lane); tr_load(d1, r1, lane);
    for (int k = 0; k < trips; k += 2) {
        const int i0 = gw + k * NGW, i1 = i0 + NGW;
        tr_finish(d0, r0, scr, lane, i0 < NI);
        d0 = TR_DESC(i0 + 2 * NGW); tr_load(d0, r0, lane);
        tr_finish(d1, r1, scr, lane, (k + 1 < trips) && i1 < NI);
        d1 = TR_DESC(i1 + 2 * NGW); tr_load(d1, r1, lane);
    }
#undef TR_DESC
}

__device__ __forceinline__ void phase0(const Params& p, LAS unsigned char* lds, int wv, int lane) {
    unsigned char* ws = p.ws;
    const int gw = blockIdx.x * 8 + wv, NGW = gridDim.x * 8;
    convert_weights<false>(p, lds, wv, lane, 0, (int)gridDim.x);
    { bf16_t* PB = (bf16_t*)(ws + WS_POOLT);
      for (int i = blockIdx.x * NTHREADS + threadIdx.x; i < 4 * 256 * 256 / 4; i += gridDim.x * NTHREADS) {
          const int e = 4 * i, g = e >> 16, d = e & 255; const f32x4 v = *(const f32x4*)(p.pool_w + e); const f32x4 sc = *(const f32x4*)(p.pool_scale + g * 256 + d);
          u32x2 o; o.x = cvt_pk_bf16(v[0] * sc[0], v[1] * sc[1]); o.y = cvt_pk_bf16(v[2] * sc[2], v[3] * sc[3]); *(u32x2*)(PB + e) = o; } }
    bf16_t* HN = (bf16_t*)(ws + WS_HN);
    for (int row = gw; row < RP; row += NGW) {
        const float* src = nullptr;
        if (row < RPV) { const int b = row / TB, pos = row - b * TB; if (pos >= 64) src = p.x + (size_t)(b * SEQ + pos - 64) * D; else if (pos >= 48) src = p.meta + (size_t)(pos - 48) * D; }
        u32x2* o8 = (u32x2*)(HN + (size_t)row * D) + lane;
        if (!src) {
#pragma unroll
            for (int j = 0; j < 8; ++j) o8[64 * j] = (u32x2){0u, 0u};
        } else {
            const f32x4* xr = (const f32x4*)src + lane; const f32x4* wr_ = (const f32x4*)p.norm_mix_w + lane;
            f32x4 v[8]; float s = 0.f;
#pragma unroll
            for (int j = 0; j < 8; ++j) { v[j] = xr[64 * j]; s += (v[j][0] * v[j][0] + v[j][1] * v[j][1]) + (v[j][2] * v[j][2] + v[j][3] * v[j][3]); }
            const float rstd = __builtin_amdgcn_rsqf(wave_sum(s) * (1.0f / D) + RMS_EPS);
#pragma unroll
            for (int j = 0; j < 8; ++j) { const f32x4 w = wr_[64 * j]; u32x2 o; o.x = cvt_pk_bf16(v[j][0] * rstd * w[0], v[j][1] * rstd * w[1]); o.y = cvt_pk_bf16(v[j][2] * rstd * w[2], v[j][3] * rstd * w[3]); o8[64 * j] = o; }
        }
    }
}

__device__ __forceinline__ void prep_phase(const Params& p, LAS unsigned char* lds, int wv, int lane_in, int n_lo, int n_hi, int w, int nw) {
    unsigned char* ws = p.ws;
    LAS float* AM = (LAS float*)(lds);
    LAS bf16_t* TM = (LAS bf16_t*)(lds + 17408);
    LAS bf16_t* QN = (LAS bf16_t*)(lds + 26624);
    LAS bf16_t* KN = (LAS bf16_t*)(lds + 44032);
    LAS bf16_t* KBT = (LAS bf16_t*)(lds + 61440);
    LAS bf16_t* VBT = (LAS bf16_t*)(lds + 79872);
    const bf16_t* QKV = (const bf16_t*)(ws + WS_QKV); const float* BA = (const float*)(ws + WS_BA); float* GL = (float*)(ws + WS_GL);
    const float qscale = 0.08838834764831845f;
    for (int ui = w; ui < (n_hi - n_lo) * 16; ui += nw) {
        const int n = n_lo + (ui >> 4), b = (ui >> 3) & 1, h = ui & 7;
        const int r0 = b * TB + n * 64;
        int lane = lane_in; asm volatile("" : "+v"(lane));
        const int fr = lane & 15, fq = lane >> 4;
        const int urec = (b * NH + h) * NCH + n;
        bf16_t* UA = (bf16_t*)p.out + (size_t)urec * 24576; bf16_t* UB = (bf16_t*)(ws + WS_PREPB) + (size_t)urec * 12288;
        bf16_t* uT = UA; bf16_t* wM = UA + 8192; bf16_t* qd = UA + 16384; bf16_t* kdT = UB; bf16_t* qkM = UB + 8192;
        float beta, gc, gcl;
        { const float bl = BA[(size_t)(r0 + lane) * 16 + h], al = BA[(size_t)(r0 + lane) * 16 + 8 + h];
          const bool valid = !(n == 0 && lane < 48);
          const float xg = al + p.dt_bias[h]; const float sp = fmaxf(xg, 0.f) + log1pf(expf(-fabsf(xg)));
          float g = valid ? -expf(p.a_log[h]) * sp : 0.f;
          beta = valid ? 1.0f / (1.0f + expf(-bl)) : 0.f;
#pragma unroll
          for (int o = 1; o < 64; o <<= 1) { const float t = __shfl_up(g, o); if (lane >= o) g += t; }
          gc = g; gcl = __shfl(gc, 63); }
        {
            const int t0 = wv * 8;
            unsigned xin[3][11]; float cw[3][4][2];
#pragma unroll
            for (int c3 = 0; c3 < 3; ++c3) {
#pragma unroll
                for (int i = 0; i < 11; ++i) { const int grow = r0 + t0 - 3 + i; xin[c3][i] = (grow >= 0) ? *(const unsigned*)(QKV + (size_t)grow * 3072 + c3 * 1024 + h * 128 + 2 * lane) : 0u; }
#pragma unroll
                for (int j = 0; j < 4; ++j) { const f32x2 w2 = *(const f32x2*)(p.conv_w + (size_t)j * 3072 + c3 * 1024 + h * 128 + 2 * lane); cw[c3][j][0] = w2[0]; cw[c3][j][1] = w2[1]; }
            }
            float kb[2][8], vb[2][8], kd[2][8];
            float y[8][3][2], ssq[8], ssk[8];
#pragma unroll
            for (int i = 0; i < 8; ++i) {
#pragma unroll
                for (int c3 = 0; c3 < 3; ++c3) { float a0 = 0.f, a1 = 0.f;
#pragma unroll
                    for (int j = 0; j < 4; ++j) { a0 += cw[c3][j][0] * bf_lo(xin[c3][i + j]); a1 += cw[c3][j][1] * bf_hi(xin[c3][i + j]); }
                    y[i][c3][0] = fast_silu(a0); y[i][c3][1] = fast_silu(a1); }
                ssq[i] = y[i][0][0] * y[i][0][0] + y[i][0][1] * y[i][0][1]; ssk[i] = y[i][1][0] * y[i][1][0] + y[i][1][1] * y[i][1][1];
            }
#pragma unroll
            for (int o = 1; o < 64; o <<= 1) {
#pragma unroll
                for (int i = 0; i < 8; ++i) { ssq[i] += __shfl_xor(ssq[i], o); ssk[i] += __shfl_xor(ssk[i], o); }
            }
#pragma unroll
            for (int i = 0; i < 8; ++i) {
                const int t = t0 + i;
                const float rq = __builtin_amdgcn_rsqf(ssq[i] + L2_EPS) * qscale, rk = __builtin_amdgcn_rsqf(ssk[i] + L2_EPS);
                const float bt = __shfl(beta, t), gct = __shfl(gc, t);
                const float eg = __expf(gct), egl = __expf(gcl - gct);
                const float q0 = y[i][0][0] * rq, q1 = y[i][0][1] * rq, k0 = y[i][1][0] * rk, k1 = y[i][1][1] * rk;
                *(LAS unsigned*)(QN + t * 136 + 2 * lane) = cvt_pk_bf16(q0, q1);
                *(LAS unsigned*)(KN + t * 136 + 2 * lane) = cvt_pk_bf16(k0, k1);
                *(unsigned*)(qd + ((((t >> 4) * 4 + (lane >> 4)) * 64 + ((lane & 15) >> 2) * 16 + (t & 15)) * 8 + 2 * (lane & 3))) = cvt_pk_bf16(q0 * eg, q1 * eg);
                kb[0][i] = k0 * bt * eg; kb[1][i] = k1 * bt * eg; vb[0][i] = y[i][2][0] * bt; vb[1][i] = y[i][2][1] * bt; kd[0][i] = k0 * egl; kd[1][i] = k1 * egl;
            }
#pragma unroll
            for (int ch = 0; ch < 2; ++ch) { const int d = 2 * lane + ch; u32x4 a, v, k;
                a.x = cvt_pk_bf16(kb[ch][0], kb[ch][1]); a.y = cvt_pk_bf16(kb[ch][2], kb[ch][3]); a.z = cvt_pk_bf16(kb[ch][4], kb[ch][5]); a.w = cvt_pk_bf16(kb[ch][6], kb[ch][7]);
                v.x = cvt_pk_bf16(vb[ch][0], vb[ch][1]); v.y = cvt_pk_bf16(vb[ch][2], vb[ch][3]); v.z = cvt_pk_bf16(vb[ch][4], vb[ch][5]); v.w = cvt_pk_bf16(vb[ch][6], vb[ch][7]);
                k.x = cvt_pk_bf16(kd[ch][0], kd[ch][1]); k.y = cvt_pk_bf16(kd[ch][2], kd[ch][3]); k.z = cvt_pk_bf16(kd[ch][4], kd[ch][5]); k.w = cvt_pk_bf16(kd[ch][6], kd[ch][7]);
                *(LAS u32x4*)(KBT + d * 72 + t0) = a; *(LAS u32x4*)(VBT + d * 72 + t0) = v;
                *(u32x4*)(kdT + ((((d >> 4) * 2 + (wv >> 2)) * 64 + (wv & 3) * 16 + (d & 15)) * 8)) = k; }
        }
        __syncthreads();
        {
            const int it = wv >> 1;
#pragma unroll
            for (int jj = 0; jj < 2; ++jj) { const int jt = (wv & 1) * 2 + jj;
                f32x4 akk = (f32x4){0.f, 0.f, 0.f, 0.f}, aqk = (f32x4){0.f, 0.f, 0.f, 0.f};
#pragma unroll
                for (int kk = 0; kk < 4; ++kk) {
                    const bf16x8 kni = *(const LAS bf16x8*)(KN + (it * 16 + fr) * 136 + kk * 32 + fq * 8);
                    const bf16x8 knj = *(const LAS bf16x8*)(KN + (jt * 16 + fr) * 136 + kk * 32 + fq * 8);
                    const bf16x8 qni = *(const LAS bf16x8*)(QN + (it * 16 + fr) * 136 + kk * 32 + fq * 8);
                    akk = __builtin_amdgcn_mfma_f32_16x16x32_bf16(kni, knj, akk, 0, 0, 0);
                    aqk = __builtin_amdgcn_mfma_f32_16x16x32_bf16(knj, qni, aqk, 0, 0, 0);
                }
                { const int j = jt * 16 + fr; const float gj = __shfl(gc, j);
#pragma unroll
                  for (int r = 0; r < 4; ++r) { const int i = it * 16 + fq * 4 + r; const float gi = __shfl(gc, i), bi = __shfl(beta, i);
                      AM[i * 68 + j] = (j < i) ? bi * akk[r] * expf(gi - gj) : 0.f; } }
                { const int i = it * 16 + fr; const float gi = __shfl(gc, i); float v[4];
#pragma unroll
                  for (int r = 0; r < 4; ++r) { const int j = jt * 16 + fq * 4 + r; const float gj = __shfl(gc, j); v[r] = (j <= i) ? aqk[r] * expf(gi - gj) : 0.f; }
                  u32x2 w; w.x = cvt_pk_bf16(v[0], v[1]); w.y = cvt_pk_bf16(v[2], v[3]);
                  *(u32x2*)(qkM + (((it * 2 + (jt >> 1)) * 64 + ((jt & 1) * 2 + (fq >> 1)) * 16 + fr) * 8 + (fq & 1) * 4)) = w; }
            }
        }
        __syncthreads();
        {
            LAS bf16_t* T11T = (LAS bf16_t*)(lds + 98304);
            LAS bf16_t* A21B = (LAS bf16_t*)(lds + 100864);
            LAS bf16_t* XT = (LAS bf16_t*)(lds + 103424);
            if (wv < 2) {
                const int o = wv * 32, c = lane & 31;
                float t[32];
#pragma unroll
                for (int i = 0; i < 32; ++i) {
                    float a0 = (c == i) ? 1.f : 0.f, a1 = 0.f, a2 = 0.f, a3 = 0.f;
#pragma unroll
                    for (int j = 0; j < (i & ~3); j += 4) { const f32x4 av = *(const LAS f32x4*)(AM + (o + i) * 68 + o + j); a0 -= av[0] * t[j]; a1 -= av[1] * t[j + 1]; a2 -= av[2] * t[j + 2]; a3 -= av[3] * t[j + 3]; }
#pragma unroll
                    for (int j = (i & ~3); j < i; ++j) a0 -= AM[(o + i) * 68 + o + j] * t[j];
                    t[i] = (a0 + a1) + (a2 + a3);
                    if (lane < 32) TM[(o + i) * 72 + o + c] = (bf16_t)(cvt_pk_bf16(t[i], 0.f) & 0xffffu);
                    else if (wv == 0) TM[i * 72 + lane] = (bf16_t)0;
                    asm volatile("" ::: "memory");
                }
                if (wv == 0 && lane < 32) {
#pragma unroll
                    for (int q = 0; q < 4; ++q) { u32x4 w; w.x = cvt_pk_bf16(t[8 * q], t[8 * q + 1]); w.y = cvt_pk_bf16(t[8 * q + 2], t[8 * q + 3]); w.z = cvt_pk_bf16(t[8 * q + 4], t[8 * q + 5]); w.w = cvt_pk_bf16(t[8 * q + 6], t[8 * q + 7]);
                        *(LAS u32x4*)(T11T + c * 40 + 8 * q) = w; }
                }
                if (wv == 0 && lane == 0) GL[urec] = expf(gcl);
            } else if (wv < 6) {
                const int e = (wv - 2) * 256 + lane * 4, i = e >> 5, k = e & 31;
                const f32x4 v = *(const LAS f32x4*)(AM + (32 + i) * 68 + k);
                u32x2 w; w.x = cvt_pk_bf16(v[0], v[1]); w.y = cvt_pk_bf16(v[2], v[3]);
                *(LAS u32x2*)(A21B + i * 40 + k) = w;
            }
            __syncthreads();
            const int it2 = (wv >> 1) & 1, jt2 = wv & 1;
            if (wv < 4) {
                const bf16x8 xa = *(const LAS bf16x8*)(A21B + (it2 * 16 + fr) * 40 + fq * 8);
                const bf16x8 yb = *(const LAS bf16x8*)(T11T + (jt2 * 16 + fr) * 40 + fq * 8);
                const f32x4 x = __builtin_amdgcn_mfma_f32_16x16x32_bf16(xa, yb, (f32x4){0.f, 0.f, 0.f, 0.f}, 0, 0, 0);
                u32x2 w; w.x = cvt_pk_bf16(x[0], x[1]); w.y = cvt_pk_bf16(x[2], x[3]);
                *(LAS u32x2*)(XT + (jt2 * 16 + fr) * 40 + it2 * 16 + fq * 4) = w;
            }
            __syncthreads();
            if (wv < 4) {
                const bf16x8 ta = *(const LAS bf16x8*)(TM + (32 + it2 * 16 + fr) * 72 + 32 + fq * 8);
                const bf16x8 xb = *(const LAS bf16x8*)(XT + (jt2 * 16 + fr) * 40 + fq * 8);
                const f32x4 r = __builtin_amdgcn_mfma_f32_16x16x32_bf16(ta, xb, (f32x4){0.f, 0.f, 0.f, 0.f}, 0, 0, 0);
#pragma unroll
                for (int q = 0; q < 4; ++q) TM[(32 + it2 * 16 + fq * 4 + q) * 72 + jt2 * 16 + fr] = (bf16_t)(cvt_pk_bf16(-r[q], 0.f) & 0xffffu);
            }
        }
        __syncthreads();
        {
#pragma unroll
            for (int ct = 0; ct < 4; ++ct) {
                f32x4 au = (f32x4){0.f, 0.f, 0.f, 0.f}, aw = (f32x4){0.f, 0.f, 0.f, 0.f};
#pragma unroll
                for (int kk = 0; kk < 2; ++kk) {
                    const bf16x8 tf = *(const LAS bf16x8*)(TM + (ct * 16 + fr) * 72 + kk * 32 + fq * 8);
                    const bf16x8 vf = *(const LAS bf16x8*)(VBT + (wv * 16 + fr) * 72 + kk * 32 + fq * 8);
                    const bf16x8 kf = *(const LAS bf16x8*)(KBT + (wv * 16 + fr) * 72 + kk * 32 + fq * 8);
                    au = __builtin_amdgcn_mfma_f32_16x16x32_bf16(tf, vf, au, 0, 0, 0);
                    aw = __builtin_amdgcn_mfma_f32_16x16x32_bf16(kf, tf, aw, 0, 0, 0);
                }
                u32x2 w1; w1.x = cvt_pk_bf16(au[0], au[1]); w1.y = cvt_pk_bf16(au[2], au[3]);
                *(u32x2*)(uT + ((wv * 4 + ct) * 64 + lane) * 4) = w1;
                u32x2 w2; w2.x = cvt_pk_bf16(aw[0], aw[1]); w2.y = cvt_pk_bf16(aw[2], aw[3]);
                *(u32x2*)(wM + (((ct * 4 + (wv >> 1)) * 64 + ((wv & 1) * 2 + (fq >> 1)) * 16 + fr) * 8 + (fq & 1) * 4)) = w2;
            }
        }
        __syncthreads();
    }
}

struct ScanRegs { bf16x8 X[4]; bf16x8 Y[2]; bf16x8 KD[2]; u32x2 UU; float gl; };
__device__ __forceinline__ void scan_load(ScanRegs& R, const bf16_t* baseA, const bf16_t* baseB, const float* GL, int unit, int es, int ct, bool roleB, int dt, int lane) {
    const bf16_t* xb = baseA + (roleB ? 16384 : 8192);
#pragma unroll
    for (int kk = 0; kk < 4; ++kk) R.X[kk] = *(const bf16x8*)(xb + ((ct * 4 + kk) * 64 + lane) * 8);
#pragma unroll
    for (int kk = 0; kk < 2; ++kk) R.KD[kk] = *(const bf16x8*)(baseB + ((dt * 2 + kk) * 64 + lane) * 8);
#pragma unroll
    for (int kk = 0; kk < 2; ++kk) R.Y[kk] = *(const bf16x8*)(baseB + 8192 + (roleB ? ((ct * 2 + kk) * 64 + lane) * 8 : 0));
    R.UU = *(const u32x2*)(baseA + (roleB ? 0 : ((es * 4 + ct) * 64 + lane) * 4));
    R.gl = GL[unit];
}
#define LDS_BARRIER() do { asm volatile("s_waitcnt lgkmcnt(0)" ::: "memory"); __builtin_amdgcn_s_barrier(); asm volatile("" ::: "memory"); } while (0)
__device__ __forceinline__ void scan_step(const ScanRegs& cur, f32x4& sacc, LAS bf16_t* SBc, LAS bf16_t* SBn, LAS bf16_t* VN, bf16_t* Orow  , int ct, bool roleB, int dt, int fr, int fq, int hcol) {
    bf16x8 sbf[4];
#pragma unroll
    for (int kk = 0; kk < 4; ++kk) sbf[kk] = *(const LAS bf16x8*)(SBc + fr * 136 + kk * 32 + fq * 8);
    f32x4 a = (f32x4){0.f, 0.f, 0.f, 0.f};
    if (!roleB) {
#pragma unroll
        for (int kk = 0; kk < 4; ++kk) a = __builtin_amdgcn_mfma_f32_16x16x32_bf16(cur.X[kk], sbf[kk], a, 0, 0, 0);
        const float v0 = bf_lo(cur.UU.x) - a[0], v1 = bf_hi(cur.UU.x) - a[1], v2 = bf_lo(cur.UU.y) - a[2], v3 = bf_hi(cur.UU.y) - a[3];
        u32x2 w; w.x = cvt_pk_bf16(v0, v1); w.y = cvt_pk_bf16(v2, v3);
        *(LAS u32x2*)(VN + fr * 72 + ct * 16 + fq * 4) = w;
    } else {
#pragma unroll
        for (int kk = 0; kk < 4; ++kk) a = __builtin_amdgcn_mfma_f32_16x16x32_bf16(sbf[kk], cur.X[kk], a, 0, 0, 0);
    }
    LDS_BARRIER();
    bf16x8 vnf[2];
#pragma unroll
    for (int kk = 0; kk < 2; ++kk) vnf[kk] = *(const LAS bf16x8*)(VN + fr * 72 + kk * 32 + fq * 8);
    sacc = sacc * cur.gl;
#pragma unroll
    for (int kk = 0; kk < 2; ++kk) sacc = __builtin_amdgcn_mfma_f32_16x16x32_bf16(cur.KD[kk], vnf[kk], sacc, 0, 0, 0);
    { u32x2 w; w.x = cvt_pk_bf16(sacc[0], sacc[1]); w.y = cvt_pk_bf16(sacc[2], sacc[3]);
      *(LAS u32x2*)(SBn + fr * 136 + dt * 16 + fq * 4) = w; }
    if (roleB) {
#pragma unroll
        for (int kk = 0; kk < 2; ++kk) a = __builtin_amdgcn_mfma_f32_16x16x32_bf16(vnf[kk], cur.Y[kk], a, 0, 0, 0);
        u32x2 w; w.x = cvt_pk_bf16(a[0], a[1]); w.y = cvt_pk_bf16(a[2], a[3]);
        *(u32x2*)(Orow + (size_t)(ct * 16 + fr) * 1024 + hcol + fq * 4) = w;
    }
    LDS_BARRIER();
}
__device__ __forceinline__ void scan_run(const Params& p, LAS unsigned char* lds, int wv, int lane, f32x4& sacc, int n_lo, int n_hi, bool init) {
    unsigned char* ws = p.ws;
    const int tid = threadIdx.x, fr = lane & 15, fq = lane >> 4;
    const int xcd_ = blockIdx.x & 7, j_ = blockIdx.x >> 3, bh_ = xcd_ * 2 + (j_ >> 3);
    const int b = bh_ >> 3, h = bh_ & 7, es = j_ & 7, e0 = es * 16;
    const int ct = wv & 3, dt = wv; const bool roleB = wv >= 4;
    LAS bf16_t* SB = (LAS bf16_t*)lds;
    LAS bf16_t* VN = (LAS bf16_t*)(lds + 8704);
    const bf16_t* PREPA = (const bf16_t*)p.out; const bf16_t* PREPB = (const bf16_t*)(ws + WS_PREPB); const float* GL = (const float*)(ws + WS_GL); bf16_t* O = (bf16_t*)(ws + WS_O);
    if (init) {
        for (int i = tid; i < 2 * 16 * 136 / 2; i += NTHREADS) ((LAS unsigned*)SB)[i] = 0u;
        __syncthreads();
        sacc = (f32x4){0.f, 0.f, 0.f, 0.f};
    }
    const int ubase = (b * NH + h) * NCH;
    const int hcol = h * 128 + e0;
    bf16_t* Ob = O + (size_t)(b * TB) * 1024;
#define SCAN_LOAD(R, n_) do { const int nn_ = (n_) < n_hi ? (n_) : n_hi - 1; const int unit_ = ubase + nn_; scan_load(R, PREPA + (size_t)unit_ * 24576, PREPB + (size_t)unit_ * 12288, GL, unit_, es, ct, roleB, dt, lane); } while (0)
#define SCAN_STEP(R, n_, SBr, SBw) scan_step(R, sacc, SBr, SBw, VN, Ob + (size_t)((n_) * 64) * 1024, ct, roleB, dt, fr, fq, hcol)
    ScanRegs r0, r1, r2, r3;
    SCAN_LOAD(r0, n_lo); SCAN_LOAD(r1, n_lo + 1); SCAN_LOAD(r2, n_lo + 2);
    LAS bf16_t* SB0 = SB; LAS bf16_t* SB1 = SB + 2176;
    for (int n = n_lo; n < n_hi; n += 4) {
        SCAN_LOAD(r3, n + 3); SCAN_STEP(r0, n, SB0, SB1);
        SCAN_LOAD(r0, n + 4); if (n + 1 < n_hi) SCAN_STEP(r1, n + 1, SB1, SB0);
        SCAN_LOAD(r1, n + 5); if (n + 2 < n_hi) SCAN_STEP(r2, n + 2, SB0, SB1);
        SCAN_LOAD(r2, n + 6); if (n + 3 < n_hi) SCAN_STEP(r3, n + 3, SB1, SB0);
    }
#undef SCAN_LOAD
#undef SCAN_STEP
    asm volatile("s_waitcnt vmcnt(0)" ::: "memory");
    __syncthreads();
}

template <int WIN>
__device__ __forceinline__ void pooled_item(const Params& p, int it, int lane) {
    const bf16_t* P = (const bf16_t*)(p.ws + WS_P); bf16_t* PO = (bf16_t*)(p.ws + WS_POOLED);
    const int rb = it >> 3, cb = it & 7;
    const int rr0 = rb * 16, prow0 = rr0 + 64 + ((rr0 >> 13) << 6);
    const int col = cb * 128 + 2 * lane;
    float v0[15 + WIN], v1[15 + WIN];
#pragma unroll
    for (int k = 0; k < 15 + WIN; ++k) { const unsigned w = *(const unsigned*)(P + (size_t)(prow0 - (WIN - 1) + k) * 1024 + col); v0[k] = bf_lo(w); v1[k] = bf_hi(w); }
    const float inv = 1.0f / (float)WIN;
#pragma unroll
    for (int i = 0; i < 16; ++i) { float a0 = 0.f, a1 = 0.f;
#pragma unroll
        for (int s2 = 0; s2 < WIN; ++s2) { a0 += v0[WIN - 1 + i - s2]; a1 += v1[WIN - 1 + i - s2]; }
        *(unsigned*)(PO + (size_t)(rr0 + i) * 1024 + col) = cvt_pk_bf16(a0 * inv - v0[WIN - 1 + i], a1 * inv - v1[WIN - 1 + i]); }
}

__device__ __forceinline__ void phase4(const Params& p, LAS unsigned char* lds, int wv, int lane) {
    unsigned char* ws = p.ws;
    const int gw = blockIdx.x * 8 + wv, NGW = gridDim.x * 8;
    { const bf16_t* O = (const bf16_t*)(ws + WS_O); const bf16_t* Z = (const bf16_t*)(ws + WS_Z); bf16_t* OG = (bf16_t*)(ws + WS_OG);
      f32x4 nw[4];
#pragma unroll
      for (int i = 0; i < 4; ++i) nw[i] = *(const f32x4*)(p.o_norm_w + (lane & 7) * 16 + 4 * i);
      for (int rr = gw; rr < RR; rr += NGW) {
          const int prow = rr + 64 + ((rr >> 13) << 6);
          const u32x4 o0 = *(const u32x4*)(O + (size_t)prow * 1024 + lane * 16), o1 = *(const u32x4*)(O + (size_t)prow * 1024 + lane * 16 + 8);
          const u32x4 z0 = *(const u32x4*)(Z + (size_t)prow * 1024 + lane * 16), z1 = *(const u32x4*)(Z + (size_t)prow * 1024 + lane * 16 + 8);
          float ov[16], zv[16];
          ov[0] = bf_lo(o0.x); ov[1] = bf_hi(o0.x); ov[2] = bf_lo(o0.y); ov[3] = bf_hi(o0.y); ov[4] = bf_lo(o0.z); ov[5] = bf_hi(o0.z); ov[6] = bf_lo(o0.w); ov[7] = bf_hi(o0.w);
          ov[8] = bf_lo(o1.x); ov[9] = bf_hi(o1.x); ov[10] = bf_lo(o1.y); ov[11] = bf_hi(o1.y); ov[12] = bf_lo(o1.z); ov[13] = bf_hi(o1.z); ov[14] = bf_lo(o1.w); ov[15] = bf_hi(o1.w);
          zv[0] = bf_lo(z0.x); zv[1] = bf_hi(z0.x); zv[2] = bf_lo(z0.y); zv[3] = bf_hi(z0.y); zv[4] = bf_lo(z0.z); zv[5] = bf_hi(z0.z); zv[6] = bf_lo(z0.w); zv[7] = bf_hi(z0.w);
          zv[8] = bf_lo(z1.x); zv[9] = bf_hi(z1.x); zv[10] = bf_lo(z1.y); zv[11] = bf_hi(z1.y); zv[12] = bf_lo(z1.z); zv[13] = bf_hi(z1.z); zv[14] = bf_lo(z1.w); zv[15] = bf_hi(z1.w);
          float ss = 0.f;
#pragma unroll
          for (int i = 0; i < 16; ++i) ss += ov[i] * ov[i];
          ss += __shfl_xor(ss, 1); ss += __shfl_xor(ss, 2); ss += __shfl_xor(ss, 4);
          const float rstd = __builtin_amdgcn_rsqf(ss * (1.0f / 128.0f) + RMS_EPS);
          float r[16];
#pragma unroll
          for (int i = 0; i < 16; ++i) r[i] = ov[i] * rstd * nw[i >> 2][i & 3] * zv[i];
          u32x4 w0, w1; w0.x = cvt_pk_bf16(r[0], r[1]); w0.y = cvt_pk_bf16(r[2], r[3]); w0.z = cvt_pk_bf16(r[4], r[5]); w0.w = cvt_pk_bf16(r[6], r[7]);
          w1.x = cvt_pk_bf16(r[8], r[9]); w1.y = cvt_pk_bf16(r[10], r[11]); w1.z = cvt_pk_bf16(r[12], r[13]); w1.w = cvt_pk_bf16(r[14], r[15]);
          *(u32x4*)(OG + (size_t)rr * 1024 + lane * 16) = w0; *(u32x4*)(OG + (size_t)rr * 1024 + lane * 16 + 8) = w1;
      } }
    for (int it = gw; it < 1024 * 8; it += NGW) {
        const int g = (it & 7) >> 1;
        if (g == 0) pooled_item<2>(p, it, lane); else if (g == 1) pooled_item<4>(p, it, lane); else if (g == 2) pooled_item<8>(p, it, lane); else pooled_item<16>(p, it, lane);
    }
}

__device__ __forceinline__ void final_phase(const Params& p, int wv, int lane) {
    const int gw = blockIdx.x * 8 + wv, NGW = gridDim.x * 8;
    const bf16_t* H2B = (const bf16_t*)(p.ws + WS_H2B);
    for (int rr = gw; rr < RR; rr += NGW) {
        const u32x4* hr = (const u32x4*)(H2B + (size_t)rr * D) + lane;
        u32x4 h[4]; float s = 0.f;
#pragma unroll
        for (int j = 0; j < 4; ++j) { h[j] = hr[64 * j];
            const float f0 = bf_lo(h[j].x), f1 = bf_hi(h[j].x), f2 = bf_lo(h[j].y), f3 = bf_hi(h[j].y), f4 = bf_lo(h[j].z), f5 = bf_hi(h[j].z), f6 = bf_lo(h[j].w), f7 = bf_hi(h[j].w);
            s += ((f0 * f0 + f1 * f1) + (f2 * f2 + f3 * f3)) + ((f4 * f4 + f5 * f5) + (f6 * f6 + f7 * f7)); }
        const float rstd = __builtin_amdgcn_rsqf(wave_sum(s) * (1.0f / D) + RMS_EPS);
#pragma unroll
        for (int j = 0; j < 4; ++j) { const int e = 8 * (lane + 64 * j); const f32x4 w0 = *(const f32x4*)(p.norm_final_w + e), w1 = *(const f32x4*)(p.norm_final_w + e + 4);
            f32x4 o0, o1; o0[0] = bf_lo(h[j].x) * rstd * w0[0]; o0[1] = bf_hi(h[j].x) * rstd * w0[1]; o0[2] = bf_lo(h[j].y) * rstd * w0[2]; o0[3] = bf_hi(h[j].y) * rstd * w0[3];
            o1[0] = bf_lo(h[j].z) * rstd * w1[0]; o1[1] = bf_hi(h[j].z) * rstd * w1[1]; o1[2] = bf_lo(h[j].w) * rstd * w1[2]; o1[3] = bf_hi(h[j].w) * rstd * w1[3];
            *(f32x4*)(p.out + (size_t)rr * D + e) = o0; *(f32x4*)(p.out + (size_t)rr * D + e + 4) = o1; }
    }
}

#define XB_TMO      128
#define XB_XCNT(j)  (256  + 64 * (j))
#define XB_XSUB(j)  (1280 + 64 * (j))
#define XB_XGEN(j)  (2304 + 64 * (j))
#define XB_TOP      3328
#define XB_TOPGEN   3392
#define XCD_BAR_WORDS 3456
#define XB_SPIN_CAP (1u << 22)
__device__ __forceinline__ unsigned xb_ld(unsigned* p)              { return __hip_atomic_load(p, __ATOMIC_RELAXED, __HIP_MEMORY_SCOPE_AGENT); }
__device__ __forceinline__ unsigned xb_add(unsigned* p, unsigned v) { return __hip_atomic_fetch_add(p, v, __ATOMIC_RELAXED, __HIP_MEMORY_SCOPE_AGENT); }
__device__ __forceinline__ unsigned xb_xcc_id() { return (unsigned)__builtin_amdgcn_s_getreg((3 << 11) | 20) & 0xFu; }
#define XB_SPIN(cond, bar) do { unsigned _sp = 0; while (cond) { __builtin_amdgcn_s_sleep(1); \
    if ((++_sp & 255u) == 0u) { if (xb_ld(&(bar)[XB_TMO])) break; if (_sp > XB_SPIN_CAP) { atomicAdd(&(bar)[XB_TMO], 1u); break; } } } } while (0)
struct XcdBarrier { unsigned* bar; unsigned x; volatile LAS unsigned* st; };
__device__ __forceinline__ XcdBarrier xcd_barrier_post(unsigned* bar, volatile LAS unsigned* st) {
    XcdBarrier b; b.bar = bar; b.x = xb_xcc_id(); b.st = st;
    if (threadIdx.x == 0) (void)xb_add(&bar[XB_XCNT(b.x)], 1u);
    return b;
}
__device__ __forceinline__ void xcd_barrier_complete(unsigned* bar, unsigned x, unsigned& nloc, unsigned& nx) {
    const unsigned G = gridDim.x * gridDim.y * gridDim.z;
    unsigned sum, cnt, mine, sp = 0u;
    for (;;) {
        sum = 0u; cnt = 0u; mine = 0u;
#pragma unroll
        for (unsigned j = 0; j < 16; ++j) { const unsigned c = xb_ld(&bar[XB_XCNT(j)]); sum += c; cnt += (c > 0u) ? 1u : 0u; mine = (j == x) ? c : mine; }
        if (sum == G) break;
        __builtin_amdgcn_s_sleep(1);
        if ((++sp & 255u) == 0u) { if (xb_ld(&bar[XB_TMO])) break; if (sp > XB_SPIN_CAP) { atomicAdd(&bar[XB_TMO], 1u); break; } }
    }
    nloc = mine > 0u ? mine : 1u; nx = cnt > 0u ? cnt : 1u;
}
__device__ __forceinline__ void xcd_barrier(const XcdBarrier& b) {
    asm volatile("s_waitcnt vmcnt(0)" ::: "memory");
    __syncthreads();
    if (threadIdx.x == 0) {
        unsigned* bar = b.bar;
        __builtin_amdgcn_s_waitcnt(0);
        unsigned nloc = b.st[0], nx = b.st[1];
        if (nloc == 0u) { xcd_barrier_complete(bar, b.x, nloc, nx); b.st[0] = nloc; b.st[1] = nx; }
        const unsigned old = xb_add(&bar[XB_XSUB(b.x)], 1u);
        const unsigned gen = old / nloc;
        if (old + 1u == (gen + 1u) * nloc) {
            __builtin_amdgcn_fence(__ATOMIC_RELEASE, "agent");
            asm volatile("s_waitcnt vmcnt(0)" ::: "memory");
            const unsigned og = xb_add(&bar[XB_TOP], 1u);
            const unsigned tg = og / nx;
            if (og + 1u == (tg + 1u) * nx) xb_add(&bar[XB_TOPGEN], 1u);
            else XB_SPIN(xb_ld(&bar[XB_TOPGEN]) == tg, bar);
            __builtin_amdgcn_fence(__ATOMIC_ACQUIRE, "agent");
            xb_add(&bar[XB_XGEN(b.x)], 1u);
            asm volatile("s_waitcnt vmcnt(0)" ::: "memory");
        } else {
            XB_SPIN(xb_ld(&bar[XB_XGEN(b.x)]) == gen, bar);
            __builtin_amdgcn_fence(__ATOMIC_ACQUIRE, "agent");
            asm volatile("s_waitcnt vmcnt(0)" ::: "memory");
        }
    }
    __syncthreads();
}

__global__ void __launch_bounds__(NTHREADS, 2) fwd_kernel(Params p) {
    extern __shared__ __attribute__((aligned(16))) unsigned char lds_raw[];
    LAS unsigned char* lds = (LAS unsigned char*)lds_raw;
    const int tid = threadIdx.x, wv = __builtin_amdgcn_readfirstlane(tid >> 6), lane = tid & 63;
    unsigned char* ws = p.ws;
    const int lo = (int)p.phase_lo, hi = (int)p.phase_hi;
#ifndef PH_MASK
#define PH_MASK 0x7ff
#endif
#define IN(k) (((PH_MASK >> (k)) & 1) && lo <= (k) && (k) < hi)
#if MK_MULTI
#define SYNC(k) do { } while (0)
#else
    cg::grid_group grid = cg::this_grid();
    volatile LAS unsigned* MISC = (volatile LAS unsigned*)(lds + LDS_BYTES - 256);
    if (tid < 32) MISC[tid] = 0u;
    __syncthreads();
    const XcdBarrier xbar = xcd_barrier_post((unsigned*)ws, MISC + 8);
#define SYNC(k) do { xcd_barrier(xbar); } while (0)
    if (hi > 1000) grid.sync();
#endif
#ifndef REP_MASK
#define REP_MASK 0
#endif
#define NREP(k) (((REP_MASK >> (k)) & 1) ? 2 : 1)
    const int G = gridDim.x, c = blockIdx.x;
    if (IN(0)) for (int rep = 0; rep < NREP(0); ++rep) { phase0(p, lds, wv, lane); SYNC(0); }
    if (IN(1)) for (int rep = 0; rep < NREP(1); ++rep) {
        pg8::Gemm g{(const bf16_t*)(ws + WS_HN), (const bf16_t*)(ws + WS_WIN), 2048, 2048, 2048, 0}; pg8::StaticOrder S; S.init(RP, NIN, G, c);
        pg8::EpiIn E{(bf16_t*)(ws + WS_QKV), (bf16_t*)(ws + WS_Z), (bf16_t*)(ws + WS_P), (unsigned char*)(ws + WS_GAB), (float*)(ws + WS_BA)};
        pg8::gemm_phase(lds, g, S, E);
        const int wc_ = (G == 256) ? ((c >= (65 * 37) % 256 && c < (65 * 37) % 256 + 32) ? c - (65 * 37) % 256 : -1) : c;
        if (wc_ >= 0) {
            pg8::Gemm g2{(const bf16_t*)(ws + WS_WB), (const bf16_t*)(ws + WS_POOLT), 1024, 256, 256, 256}; pg8::StaticOrder S; S.init(2048, 1024, G, wc_);
            pg8::EpiPlain E2{(bf16_t*)(ws + WS_WEFF), 1024};
            pg8::gemm_phase(lds, g2, S, E2); }
        { constexpr int NFULL = (65 * 37) % 256; if (G == 256 && c >= NFULL) convert_weights<true>(p, lds, wv, lane, NFULL, 256 - NFULL); else if (G != 256) convert_weights<true>(p, lds, wv, lane, 0, G); }
        SYNC(1); }
    if (IN(2) && IN(3)) {
        f32x4 sacc = (f32x4){0.f, 0.f, 0.f, 0.f};
        const bool split = (G == 256);
        const int nst = split ? 4 : 2;
        for (int st = 0; st < nst; ++st) {
            int plo, phi, slo, shi;
            if (split) { plo = st == 0 ? 0 : (st == 1 ? 96 : (st == 2 ? 128 : NCH)); phi = st == 0 ? 96 : (st == 1 ? 128 : NCH);
                         slo = st <= 1 ? 0 : (st == 2 ? 96 : 128); shi = st == 0 ? 0 : (st == 1 ? 96 : (st == 2 ? 128 : NCH)); }
            else { plo = st == 0 ? 0 : NCH; phi = NCH; slo = 0; shi = st == 0 ? 0 : NCH; }
            const bool scanner = (c < 128) && (st > 0);
            const bool all_prep = !split || st == 0;
            if (scanner) { if (slo < shi) scan_run(p, lds, wv, lane, sacc, slo, shi, slo == 0); }
            else if (plo < phi) prep_phase(p, lds, wv, lane, plo, phi, all_prep ? c : c - 128, all_prep ? G : 128);
            SYNC(2);
        }
    }
    if (IN(4)) for (int rep = 0; rep < NREP(4); ++rep) { phase4(p, lds, wv, lane); SYNC(4); }
    if (IN(6)) for (int rep = 0; rep < NREP(6); ++rep) {
        pg8::StaticOrder S; S.init(RR, 2048, G, c);
        { pg8::Gemm g{(const bf16_t*)(ws + WS_OG), (const bf16_t*)(ws + WS_WA), 1024, 1024, 1024, 0};
          pg8::EpiMerge<false> E{(const unsigned char*)(ws + WS_GAB), (bf16_t*)(ws + WS_MERGED)}; pg8::gemm_phase(lds, g, S, E); }
        { pg8::Gemm g{(const bf16_t*)(ws + WS_POOLED), (const bf16_t*)(ws + WS_WEFF), 1024, 1024, 1024, 0};
          pg8::EpiMerge<true> E{(const unsigned char*)(ws + WS_GAB), (bf16_t*)(ws + WS_MERGED)}; pg8::gemm_phase(lds, g, S, E); }
        SYNC(6); }
    if (IN(7)) for (int rep = 0; rep < NREP(7); ++rep) {
        pg8::Gemm g{(const bf16_t*)(ws + WS_MERGED), (const bf16_t*)(ws + WS_WOUT), 2048, 2048, 2048, 0}; pg8::StaticOrder S; S.init(RR, 2048, G, c);
        pg8::EpiOut E{p.x, (bf16_t*)(ws + WS_H1B), (float*)(ws + WS_SS1)};
        pg8::gemm_phase(lds, g, S, E); SYNC(7); }
    if (IN(8)) for (int rep = 0; rep < NREP(8); ++rep) {
        pg8::Gemm g{(const bf16_t*)(ws + WS_H1B), (const bf16_t*)(ws + WS_WGU), 2048, 2048, 2048, 0}; pg8::StaticOrder S; S.init(RR, 2 * FFN, G, c);
        pg8::Unit u0; const bool has0 = S.next(0, u0); const int pm0 = has0 ? u0.pm : -1;
        LAS float* RS = (LAS float*)(lds + 135168);
        if (has0 && tid < 256) { const f32x4* sp = (const f32x4*)((const float*)(ws + WS_SS1) + (size_t)(pm0 * 256 + tid) * 32); float ss = 0.f;
#pragma unroll
            for (int i = 0; i < 8; ++i) { const f32x4 q = sp[i]; ss += (q[0] + q[1]) + (q[2] + q[3]); }
            RS[tid] = __builtin_amdgcn_rsqf(ss * (1.0f / 2048.0f) + RMS_EPS); }
        __syncthreads();
        pg8::EpiGU E{(const float*)(ws + WS_SS1), (bf16_t*)(ws + WS_HIDDEN), RS, pm0};
        pg8::gemm_phase(lds, g, S, E); SYNC(8); }
    if (IN(9)) {
        pg8::Gemm g{(const bf16_t*)(ws + WS_HIDDEN), (const bf16_t*)(ws + WS_WD), FFN, FFN, FFN, 0}; pg8::StaticOrder S; S.init(RR, 2048, G, c);
        pg8::EpiDown E{(const bf16_t*)(ws + WS_H1B), (bf16_t*)(ws + WS_H2B)};
        pg8::gemm_phase(lds, g, S, E); SYNC(9); }
    if (IN(10)) final_phase(p, wv, lane);
#ifdef DIGEST_OFF
    if (lo <= 11 && 11 < hi) {
        const bf16_t* src = (const bf16_t*)(ws + (size_t)DIGEST_OFF * MiB);
        for (size_t i = (size_t)blockIdx.x * NTHREADS + tid; i < (size_t)RR * D; i += (size_t)gridDim.x * NTHREADS)
            p.out[i] = __uint_as_float((unsigned)src[(i * DIGEST_STRIDE) % (size_t)DIGEST_N] << 16);
    }
#endif
#undef IN
#undef SYNC
}

extern "C" void kernel_launch(void* const* d_in, const int* in_sizes, int n_in, void* d_out, int out_size, void* d_ws, size_t ws_size, hipStream_t stream) {
    static int grid = 0;
    if (grid == 0) {
        if (n_in != 18 || ws_size < WS_END) { fprintf(stderr, "kernel_launch: unexpected n_in %d or ws_size %zu\n", n_in, ws_size); grid = -1; return; }
        int dev = 0, cus = 0, per_cu = 0;
        hipGetDevice(&dev); hipDeviceGetAttribute(&cus, hipDeviceAttributeMultiprocessorCount, dev);
        if (hipFuncSetAttribute((const void*)fwd_kernel, hipFuncAttributeMaxDynamicSharedMemorySize, LDS_BYTES) != hipSuccess) { fprintf(stderr, "kernel_launch: hipFuncSetAttribute failed\n"); grid = -1; return; }
        hipOccupancyMaxActiveBlocksPerMultiprocessor(&per_cu, (const void*)fwd_kernel, NTHREADS, LDS_BYTES);
        (void)hipGetLastError();
        if (per_cu < 1) { fprintf(stderr, "kernel_launch: occupancy query says %d blocks per CU\n", per_cu); }
        grid = cus;
    }
    if (grid < 0) return;
    Params p{};
    p.x = (const float*)d_in[0]; p.meta = (const float*)d_in[1]; p.norm_mix_w = (const float*)d_in[2]; p.w_in = (const float*)d_in[3]; p.conv_w = (const float*)d_in[4];
    p.a_log = (const float*)d_in[5]; p.dt_bias = (const float*)d_in[6]; p.o_norm_w = (const float*)d_in[7]; p.w_proj_a = (const float*)d_in[8]; p.pool_w = (const float*)d_in[9];
    p.pool_scale = (const float*)d_in[10]; p.w_proj_b = (const float*)d_in[11]; p.w_out = (const float*)d_in[12]; p.norm_ffn_w = (const float*)d_in[13]; p.w_gate = (const float*)d_in[14];
    p.w_up = (const float*)d_in[15]; p.w_down = (const float*)d_in[16]; p.norm_final_w = (const float*)d_in[17];
    p.out = (float*)d_out; p.ws = (unsigned char*)d_ws;
#if MK_MULTI
    for (int ph = 0; ph <= 11; ++ph) { p.phase_lo = ph; p.phase_hi = ph + 1; hipLaunchKernelGGL(fwd_kernel, dim3(grid), dim3(NTHREADS), LDS_BYTES, stream, p); }
#else
    p.phase_lo = 0; p.phase_hi = 12;
    if (hipMemsetAsync(d_ws, 0, 16384, stream) != hipSuccess) { fprintf(stderr, "kernel_launch: memset of the barrier words failed\n"); return; }
    void* args[] = {&p};
    hipError_t e = hipLaunchCooperativeKernel((const void*)fwd_kernel, dim3(grid), dim3(NTHREADS), args, LDS_BYTES, stream);
    if (e != hipSuccess) fprintf(stderr, "cooperative launch failed: %s (grid %d)\n", hipGetErrorString(e), grid);
#endif
}
```

```cpp
#include <hip/hip_runtime.h>
#include <hip/hip_cooperative_groups.h>
#include <cstdio>
#include <cstdint>
namespace cg = cooperative_groups;

#define LAS __attribute__((address_space(3)))
typedef unsigned short bf16_t;
typedef short bf16x8 __attribute__((ext_vector_type(8)));
typedef float f32x4 __attribute__((ext_vector_type(4)));
typedef float f32x2 __attribute__((ext_vector_type(2)));
typedef unsigned u32x4 __attribute__((ext_vector_type(4)));
typedef unsigned u32x2 __attribute__((ext_vector_type(2)));

#ifndef MK_MULTI
#define MK_MULTI 0
#endif

constexpr int D = 2048, SEQ = 8192, NMETA = 16, TB = 8256  , RPV = 2 * TB  , RP = 16640  , RR = 16384;
constexpr int NCH = 129, NH = 8, HD = 128, NUNIT = 2 * NCH * NH  , UNIT_EL = 36864;
constexpr int FFN = 5632, NIN = 9472;
constexpr float RMS_EPS = 1e-6f, L2_EPS = 1e-6f;
constexpr int NTHREADS = 512;
constexpr int LDS_BYTES = 147456;

constexpr size_t MiB = 1u << 20;
constexpr size_t WS_BA = 1 * MiB, WS_GL = 2 * MiB + 512 * 1024, WS_SS1 = 3 * MiB;
constexpr size_t WS_WIN = 8 * MiB, WS_WA = 45 * MiB, WS_WB = 49 * MiB, WS_POOLT = 53 * MiB;
constexpr size_t WS_WOUT = 54 * MiB, WS_WGU = 62 * MiB, WS_WD = 106 * MiB;
constexpr size_t WS_PREPB = 128 * MiB;
constexpr size_t WS_HN = 128 * MiB, WS_QKV = 200 * MiB, WS_Z = 298 * MiB, WS_P = 331 * MiB, WS_GAB = 364 * MiB;
constexpr size_t WS_O = 200 * MiB, WS_OG = 233 * MiB, WS_POOLED = 266 * MiB, WS_ZB = 128 * MiB, WS_MERGED = 160 * MiB, WS_H1B = 364 * MiB, WS_HIDDEN = 128 * MiB;
constexpr size_t WS_H2B = 428 * MiB;
constexpr size_t WS_WEFF = 494 * MiB;
constexpr size_t WS_END = 498 * MiB;
static_assert(WS_PREPB + (size_t)NUNIT * 12288 * 2 <= WS_QKV && (size_t)NUNIT * 24576 * 2 <= (size_t)RR * D * 4, "prep records");
static_assert(WS_GAB + (size_t)RP * 4096 * 2 <= WS_END, "gab");
static_assert(WS_HIDDEN + (size_t)RR * FFN * 2 <= WS_H1B, "hidden");

struct Params {
    const float* x; const float* meta; const float* norm_mix_w; const float* w_in; const float* conv_w; const float* a_log; const float* dt_bias; const float* o_norm_w;
    const float* w_proj_a; const float* pool_w; const float* pool_scale; const float* w_proj_b; const float* w_out; const float* norm_ffn_w; const float* w_gate; const float* w_up;
    const float* w_down; const float* norm_final_w;
    float* out; unsigned char* ws;
    long long phase_lo, phase_hi;
};

typedef __bf16 bf16x2_t __attribute__((ext_vector_type(2)));
__device__ __forceinline__ unsigned cvt_pk_bf16(float lo, float hi) { const f32x2 v = {lo, hi}; const bf16x2_t b = __builtin_convertvector(v, bf16x2_t); return __builtin_bit_cast(unsigned, b); }
__device__ __forceinline__ float bf_lo(unsigned w) { return __uint_as_float(w << 16); }
__device__ __forceinline__ float bf_hi(unsigned w) { return __uint_as_float(w & 0xffff0000u); }
__device__ __forceinline__ float fast_sigmoid(float x) { return __builtin_amdgcn_rcpf(1.0f + __expf(-x)); }
__device__ __forceinline__ float fast_silu(float x) { return x * fast_sigmoid(x); }
__device__ __forceinline__ float wave_sum(float v) {
#pragma unroll
    for (int o = 1; o < 64; o <<= 1) v += __shfl_xor(v, o);
    return v;
}
#define LDS_WAIT() asm volatile("s_waitcnt lgkmcnt(0)" ::: "memory")

namespace pg8 {
constexpr int BM = 256, BK = 64, HALF = 128, HTB = HALF * BK * 2, STAGE_BYTES = 8 * HTB, NXCD = 8, WGM = 8;
__host__ __device__ __forceinline__ int lds_byte(int r, int c) { const int st = (r >> 4) * 2 + (c >> 5), rr = r & 15, cc = c & 31, ob = rr * 64 + cc * 2; return st * 1024 + (ob ^ (((ob >> 9) & 1) << 5)); }
__host__ __device__ __forceinline__ void stage_rc(int b, int& R, int& C) { const int st = b / 1024, sb = b % 1024, swz = sb ^ (((sb >> 9) & 1) << 5); R = (st >> 1) * 16 + swz / 64; C = (st & 1) * 32 + (swz % 64) / 2; }
__host__ __device__ __forceinline__ int perm32(int rho) { const int n = rho >> 4, i = rho & 15; return 8 * (i >> 2) + 4 * n + (i & 3); }

struct Unit { int pm, pn; };
struct Gemm { const bf16_t* A; const bf16_t* Bt; int lda, ldb, K, a_pn_off; };

struct StaticOrder {
    int nM, nN, nwg, G, c;
    __device__ void init(int M, int N, int G_, int c_) { nM = M / BM; nN = N / BM; nwg = nM * nN; G = G_; c = c_; }
    __device__ bool next(int i, Unit& u) const {
        const long L = (long)i * G + c; if (L >= nwg) return false;
        int wgid = (int)L; { const int q = nwg / NXCD, r = nwg % NXCD, xcd = wgid % NXCD, off = wgid / NXCD; wgid = (xcd < r ? xcd * (q + 1) : r * (q + 1) + (xcd - r) * q) + off; }
        const int nig = WGM * nN, gid = wgid / nig, fm = gid * WGM, gsz = (nM - fm) < WGM ? (nM - fm) : WGM;
        u.pm = fm + ((wgid % nig) % gsz); u.pn = (wgid % nig) / gsz; return true;
    }
};

template <class Epi>
__device__ __forceinline__ void gemm_phase(LAS unsigned char* lds, const Gemm g, const StaticOrder& S, const Epi& E) {
    const int tid = threadIdx.x, wid = __builtin_amdgcn_readfirstlane(tid >> 6), lane = tid & 63, wr = wid >> 2, wc = wid & 3, fr = lane & 15, fq = lane >> 4;
    const int nt = g.K / BK;
    unsigned voffA[2], voffB[2];
#pragma unroll
    for (int i = 0; i < 2; ++i) { int R, C; stage_rc(tid * 16 + i * 8192, R, C); const int Rb = (R & ~31) + perm32(R & 31);
        voffA[i] = (unsigned)(R * g.lda + C) * 2u; voffB[i] = (unsigned)(Rb * g.ldb + C) * 2u; }
    const size_t kstep = (size_t)(BK * 2);
    const size_t hstepA = (size_t)HALF * g.lda * 2, hstepB = (size_t)HALF * g.ldb * 2;
    const unsigned ldsw = (unsigned)wid * 1024u;
    const int aoff = lds_byte(wr * 64 + fr, fq * 8), boff = lds_byte(wc * 32 + fr, fq * 8);
#define PG8_SA(b, h) (((b) * 2 + (h)) * HTB)
#define PG8_SB(b, h) ((4 + (b) * 2 + (h)) * HTB)
#define PG8_STAGE(bufoff, gbase, voff) do { _Pragma("unroll") for (int _i = 0; _i < 2; ++_i) \
        __builtin_amdgcn_global_load_lds((const unsigned*)((const char*)(gbase) + (voff)[_i]), (LAS unsigned*)(lds + (bufoff) + ldsw + _i * 8192), 16, 0, 0); } while (0)
#define PG8_LDA(dst, b, h) do { _Pragma("unroll") for (int m = 0; m < 4; ++m) _Pragma("unroll") for (int k = 0; k < 2; ++k) dst[m][k] = *(const LAS bf16x8*)(lds + PG8_SA(b, h) + aoff + m * 2048 + k * 1024); } while (0)
#define PG8_LDB(dst, b, h) do { _Pragma("unroll") for (int n = 0; n < 2; ++n) _Pragma("unroll") for (int k = 0; k < 2; ++k) dst[n][k] = *(const LAS bf16x8*)(lds + PG8_SB(b, h) + boff + n * 2048 + k * 1024); } while (0)
#define PG8_MMA(ai, bj, At, Bt) do { __builtin_amdgcn_s_setprio(1); _Pragma("unroll") for (int m = 0; m < 4; ++m) _Pragma("unroll") for (int n = 0; n < 2; ++n) _Pragma("unroll") for (int k = 0; k < 2; ++k) \
        acc[ai][bj][m][n] = __builtin_amdgcn_mfma_f32_16x16x32_bf16(Bt[n][k], At[m][k], acc[ai][bj][m][n], 0, 0, 0); __builtin_amdgcn_s_setprio(0); } while (0)
#define PG8_WAIT_V(n) asm volatile("s_waitcnt vmcnt(" #n ")" ::: "memory")
#define PG8_WAIT_L(n) asm volatile("s_waitcnt lgkmcnt(" #n ")" ::: "memory")
#define PG8_BAR __builtin_amdgcn_s_barrier()
#define PG8_SCHED __builtin_amdgcn_sched_barrier(0)
    Unit cur, nxt; int ui = 0;
    if (!S.next(0, cur)) return;
    f32x4 acc[2][2][4][2];
#pragma unroll
    for (int a = 0; a < 2; ++a)
#pragma unroll
        for (int b = 0; b < 2; ++b)
#pragma unroll
            for (int m = 0; m < 4; ++m)
#pragma unroll
                for (int n = 0; n < 2; ++n) acc[a][b][m][n] = (f32x4){0.f, 0.f, 0.f, 0.f};
    bf16x8 At[4][2], B0[2][2], B1[2][2];
    const char* cA = (const char*)g.A + (size_t)cur.pm * 2 * hstepA + (size_t)cur.pn * g.a_pn_off * 2; const char* cB = (const char*)g.Bt + (size_t)cur.pn * 2 * hstepB;
    PG8_STAGE(PG8_SB(0, 0), cB, voffB); PG8_STAGE(PG8_SB(0, 1), cB + hstepB, voffB); PG8_STAGE(PG8_SA(0, 0), cA, voffA); PG8_STAGE(PG8_SA(0, 1), cA + hstepA, voffA);
    if (wr == 1) PG8_BAR;
    PG8_WAIT_V(2); PG8_BAR;
    PG8_STAGE(PG8_SB(1, 0), cB + kstep, voffB); PG8_STAGE(PG8_SA(1, 0), cA + kstep, voffA); PG8_STAGE(PG8_SB(1, 1), cB + hstepB + kstep, voffB);
    PG8_WAIT_V(6); PG8_BAR;
    for (;;) {
        const bool has_next = S.next(ui + 1, nxt);
        const char* nA = has_next ? (const char*)g.A + (size_t)nxt.pm * 2 * hstepA + (size_t)nxt.pn * g.a_pn_off * 2 : cA; const char* nB = has_next ? (const char*)g.Bt + (size_t)nxt.pn * 2 * hstepB : cB;
#pragma unroll 1
        for (int t = 0; t < nt; t += 2) {
            const bool last = (t == nt - 2);
            const char* a1 = cA + (size_t)(t + 1) * kstep;
            const char* a2 = last ? nA : cA + (size_t)(t + 2) * kstep; const char* b2 = last ? nB : cB + (size_t)(t + 2) * kstep;
            const char* a3 = a2 + kstep; const char* b3 = b2 + kstep;
            PG8_LDB(B0, 0, 0); PG8_LDB(B1, 0, 1); PG8_SCHED; PG8_LDA(At, 0, 0); PG8_STAGE(PG8_SA(1, 1), a1 + hstepA, voffA);
            PG8_WAIT_V(8); PG8_WAIT_L(0); PG8_BAR; PG8_MMA(0, 0, At, B0); PG8_MMA(0, 1, At, B1); PG8_BAR; PG8_SCHED;
            PG8_LDA(At, 0, 1); PG8_STAGE(PG8_SB(0, 0), b2, voffB); PG8_STAGE(PG8_SB(0, 1), b2 + hstepB, voffB); PG8_STAGE(PG8_SA(0, 0), a2, voffA);
            PG8_WAIT_V(8); PG8_WAIT_L(0); PG8_BAR; PG8_MMA(1, 0, At, B0); PG8_MMA(1, 1, At, B1); PG8_BAR; PG8_SCHED;
            PG8_LDB(B0, 1, 0); PG8_LDB(B1, 1, 1); PG8_SCHED; PG8_LDA(At, 1, 0); PG8_STAGE(PG8_SA(0, 1), a2 + hstepA, voffA);
            PG8_WAIT_V(8); PG8_WAIT_L(0); PG8_BAR; PG8_MMA(0, 0, At, B0); PG8_MMA(0, 1, At, B1); PG8_BAR; PG8_SCHED;
            PG8_LDA(At, 1, 1); PG8_STAGE(PG8_SB(1, 0), b3, voffB); PG8_STAGE(PG8_SB(1, 1), b3 + hstepB, voffB); PG8_STAGE(PG8_SA(1, 0), a3, voffA);
            PG8_WAIT_V(8); PG8_WAIT_L(0); PG8_BAR; PG8_MMA(1, 0, At, B0); PG8_MMA(1, 1, At, B1); PG8_BAR; PG8_SCHED;
        }
        if (wr == 0) PG8_BAR;
        E(acc, cur, wr, wc, fr, fq);
        if (!has_next) break;
#pragma unroll
        for (int a = 0; a < 2; ++a)
#pragma unroll
            for (int b = 0; b < 2; ++b)
#pragma unroll
                for (int m = 0; m < 4; ++m)
#pragma unroll
                    for (int n = 0; n < 2; ++n) acc[a][b][m][n] = (f32x4){0.f, 0.f, 0.f, 0.f};
        cur = nxt; cA = nA; cB = nB; ++ui;
        if (wr == 1) PG8_BAR;
    }
    PG8_WAIT_V(0);
    PG8_BAR;
#undef PG8_SA
#undef PG8_SB
#undef PG8_STAGE
#undef PG8_LDA
#undef PG8_LDB
#undef PG8_MMA
#undef PG8_WAIT_V
#undef PG8_WAIT_L
#undef PG8_BAR
#undef PG8_SCHED
}

typedef f32x4 AccT[2][2][4][2];
template <int ACT  >
__device__ __forceinline__ void store_tile_bf16(const AccT& acc, bf16_t* base  , int ld, int row0) {
#pragma unroll
    for (int ai = 0; ai < 2; ++ai)
#pragma unroll
        for (int m = 0; m < 4; ++m) { bf16_t* rowp = base + (size_t)(row0 + ai * HALF + m * 16) * ld;
#pragma unroll
            for (int bj = 0; bj < 2; ++bj) { f32x4 v0 = acc[ai][bj][m][0], v1 = acc[ai][bj][m][1];
                if (ACT == 1) { for (int i = 0; i < 4; ++i) { v0[i] = fast_silu(v0[i]); v1[i] = fast_silu(v1[i]); } }
                if (ACT == 2) { for (int i = 0; i < 4; ++i) { v0[i] = fast_sigmoid(v0[i]); v1[i] = fast_sigmoid(v1[i]); } }
                u32x4 w; w.x = cvt_pk_bf16(v0[0], v0[1]); w.y = cvt_pk_bf16(v0[2], v0[3]); w.z = cvt_pk_bf16(v1[0], v1[1]); w.w = cvt_pk_bf16(v1[2], v1[3]);
                *(u32x4*)(rowp + bj * HALF) = w; } }
}
__device__ __forceinline__ unsigned q8(float x) { return (unsigned)(fast_sigmoid(x) * 255.0f + 0.5f); }
__device__ __forceinline__ void store_tile_gate_u8(const AccT& acc, unsigned char* base  , int row0) {
#pragma unroll
    for (int ai = 0; ai < 2; ++ai)
#pragma unroll
        for (int m = 0; m < 4; ++m) { unsigned char* rowp = base + (size_t)(row0 + ai * HALF + m * 16) * 4096;
#pragma unroll
            for (int bj = 0; bj < 2; ++bj) { const f32x4 v0 = acc[ai][bj][m][0], v1 = acc[ai][bj][m][1];
                u32x2 w; w.x = q8(v0[0]) | (q8(v0[1]) << 8) | (q8(v0[2]) << 16) | (q8(v0[3]) << 24); w.y = q8(v1[0]) | (q8(v1[1]) << 8) | (q8(v1[2]) << 16) | (q8(v1[3]) << 24);
                *(u32x2*)(rowp + bj * HALF) = w; } }
}
struct EpiIn {
    bf16_t* QKV; bf16_t* Z; bf16_t* P; unsigned char* GAB; float* BA;
    __device__ __forceinline__ void operator()(const AccT& acc, const Unit& u, int wr, int wc, int fr, int fq) const {
        const int pn = u.pn, row0 = u.pm * BM + wr * 64 + fr, cl = wc * 32 + 8 * fq;
        if (pn == 36) {
            if (wc == 0 && fq < 2) {
#pragma unroll
                for (int ai = 0; ai < 2; ++ai)
#pragma unroll
                    for (int m = 0; m < 4; ++m) { float* q = BA + (size_t)(row0 + ai * HALF + m * 16) * 16 + 8 * fq; *(f32x4*)q = acc[ai][0][m][0]; *(f32x4*)(q + 4) = acc[ai][0][m][1]; }
            }
            return;
        }
        if (pn < 12) store_tile_bf16<0>(acc, QKV + pn * 256 + cl, 3072, row0);
        else if (pn < 16) store_tile_bf16<1>(acc, Z + (pn - 12) * 256 + cl, 1024, row0);
        else if (pn < 20) store_tile_bf16<0>(acc, P + (pn - 16) * 256 + cl, 1024, row0);
        else store_tile_gate_u8(acc, GAB + (pn - 20) * 256 + cl, row0);
    }
};
struct EpiPlain {
    bf16_t* O; int ld;
    __device__ __forceinline__ void operator()(const AccT& acc, const Unit& u, int wr, int wc, int fr, int fq) const {
        store_tile_bf16<0>(acc, O + u.pn * 256 + wc * 32 + 8 * fq, ld, u.pm * BM + wr * 64 + fr);
    }
};
template <bool SECOND> struct EpiMerge {
    const unsigned char* GAB; bf16_t* MERGED;
    __device__ __forceinline__ void operator()(const AccT& acc, const Unit& u, int wr, int wc, int fr, int fq) const {
        const int row0 = u.pm * BM + wr * 64 + fr, cl = u.pn * 256 + wc * 32 + 8 * fq;
#pragma unroll
        for (int ai = 0; ai < 2; ++ai)
#pragma unroll
            for (int m = 0; m < 4; ++m) { const int rr = row0 + ai * HALF + m * 16; const int prow = rr + 64 + ((rr >> 13) << 6);
                const unsigned char* gp = GAB + (size_t)prow * 4096 + (SECOND ? 2048 : 0) + cl; bf16_t* mp = MERGED + (size_t)rr * 2048 + cl;
#pragma unroll
                for (int bj = 0; bj < 2; ++bj) { const u32x2 gw = *(const u32x2*)(gp + bj * HALF); const f32x4 v0 = acc[ai][bj][m][0] * (1.0f / 255.0f), v1 = acc[ai][bj][m][1] * (1.0f / 255.0f);
                    float r0 = (float)(gw.x & 0xffu) * v0[0], r1 = (float)((gw.x >> 8) & 0xffu) * v0[1], r2 = (float)((gw.x >> 16) & 0xffu) * v0[2], r3 = (float)(gw.x >> 24) * v0[3];
                    float r4 = (float)(gw.y & 0xffu) * v1[0], r5 = (float)((gw.y >> 8) & 0xffu) * v1[1], r6 = (float)((gw.y >> 16) & 0xffu) * v1[2], r7 = (float)(gw.y >> 24) * v1[3];
                    if (SECOND) { const u32x4 mw = *(const u32x4*)(mp + bj * HALF);
                        r0 += bf_lo(mw.x); r1 += bf_hi(mw.x); r2 += bf_lo(mw.y); r3 += bf_hi(mw.y); r4 += bf_lo(mw.z); r5 += bf_hi(mw.z); r6 += bf_lo(mw.w); r7 += bf_hi(mw.w); }
                    u32x4 w; w.x = cvt_pk_bf16(r0, r1); w.y = cvt_pk_bf16(r2, r3); w.z = cvt_pk_bf16(r4, r5); w.w = cvt_pk_bf16(r6, r7);
                    *(u32x4*)(mp + bj * HALF) = w; } }
    }
};
struct EpiOut {
    const float* x; bf16_t* H1B; float* SS1;
    __device__ __forceinline__ void operator()(const AccT& acc, const Unit& u, int wr, int wc, int fr, int fq) const {
        const int row0 = u.pm * BM + wr * 64 + fr, cl = u.pn * 256 + wc * 32 + 8 * fq;
#pragma unroll
        for (int ai = 0; ai < 2; ++ai)
#pragma unroll
            for (int m = 0; m < 4; ++m) { const int rr = row0 + ai * HALF + m * 16; const size_t off = (size_t)rr * 2048 + cl; float ss = 0.f;
#pragma unroll
                for (int bj = 0; bj < 2; ++bj) { const f32x4 x0 = *(const f32x4*)(x + off + bj * HALF), x1 = *(const f32x4*)(x + off + bj * HALF + 4);
                    const f32x4 h0 = x0 + acc[ai][bj][m][0], h1 = x1 + acc[ai][bj][m][1];
                    ss += (h0[0] * h0[0] + h0[1] * h0[1]) + (h0[2] * h0[2] + h0[3] * h0[3]) + (h1[0] * h1[0] + h1[1] * h1[1]) + (h1[2] * h1[2] + h1[3] * h1[3]);
                    u32x4 w; w.x = cvt_pk_bf16(h0[0], h0[1]); w.y = cvt_pk_bf16(h0[2], h0[3]); w.z = cvt_pk_bf16(h1[0], h1[1]); w.w = cvt_pk_bf16(h1[2], h1[3]);
                    *(u32x4*)(H1B + off + bj * HALF) = w; }
                ss += __shfl_xor(ss, 16); ss += __shfl_xor(ss, 32);
                if (fq == 0) SS1[(size_t)rr * 32 + u.pn * 4 + wc] = ss; }
    }
};
struct EpiGU {
    const float* SS1; bf16_t* HID; const LAS float* RS; int pm0;
    __device__ __forceinline__ void operator()(const AccT& acc, const Unit& u, int wr, int wc, int fr, int fq) const {
        const int row0 = u.pm * BM + wr * 64 + fr, cl = u.pn * 128 + wc * 32 + 8 * fq;
#pragma unroll
        for (int ai = 0; ai < 2; ++ai)
#pragma unroll
            for (int m = 0; m < 4; ++m) { const int rr = row0 + ai * HALF + m * 16; float rstd;
                if (u.pm == pm0) rstd = RS[ai * HALF + wr * 64 + m * 16 + fr];
                else { const f32x4* sp = (const f32x4*)(SS1 + (size_t)rr * 32) + 2 * fq; float ss;
                    { const f32x4 s0 = sp[0], s1 = sp[1]; ss = ((s0[0] + s0[1]) + (s0[2] + s0[3])) + ((s1[0] + s1[1]) + (s1[2] + s1[3])); }
                    ss += __shfl_xor(ss, 16); ss += __shfl_xor(ss, 32);
                    rstd = __builtin_amdgcn_rsqf(ss * (1.0f / 2048.0f) + RMS_EPS); }
                const f32x4 g0 = acc[ai][0][m][0] * rstd, g1 = acc[ai][0][m][1] * rstd, u0 = acc[ai][1][m][0] * rstd, u1 = acc[ai][1][m][1] * rstd;
                u32x4 w; w.x = cvt_pk_bf16(fast_silu(g0[0]) * u0[0], fast_silu(g0[1]) * u0[1]); w.y = cvt_pk_bf16(fast_silu(g0[2]) * u0[2], fast_silu(g0[3]) * u0[3]);
                w.z = cvt_pk_bf16(fast_silu(g1[0]) * u1[0], fast_silu(g1[1]) * u1[1]); w.w = cvt_pk_bf16(fast_silu(g1[2]) * u1[2], fast_silu(g1[3]) * u1[3]);
                *(u32x4*)(HID + (size_t)rr * FFN + cl) = w; }
    }
};
struct EpiDown {
    const bf16_t* H1B; bf16_t* H2B;
    __device__ __forceinline__ void operator()(const AccT& acc, const Unit& u, int wr, int wc, int fr, int fq) const {
        const int row0 = u.pm * BM + wr * 64 + fr, cl = u.pn * 256 + wc * 32 + 8 * fq;
#pragma unroll
        for (int ai = 0; ai < 2; ++ai)
#pragma unroll
            for (int m = 0; m < 4; ++m) { const size_t off = (size_t)(row0 + ai * HALF + m * 16) * 2048 + cl;
#pragma unroll
                for (int bj = 0; bj < 2; ++bj) { const u32x4 hw = *(const u32x4*)(H1B + off + bj * HALF); const f32x4 v0 = acc[ai][bj][m][0], v1 = acc[ai][bj][m][1];
                    u32x4 w; w.x = cvt_pk_bf16(bf_lo(hw.x) + v0[0], bf_hi(hw.x) + v0[1]); w.y = cvt_pk_bf16(bf_lo(hw.y) + v0[2], bf_hi(hw.y) + v0[3]);
                    w.z = cvt_pk_bf16(bf_lo(hw.z) + v1[0], bf_hi(hw.z) + v1[1]); w.w = cvt_pk_bf16(bf_lo(hw.w) + v1[2], bf_hi(hw.w) + v1[3]);
                    *(u32x4*)(H2B + off + bj * HALF) = w; } }
    }
};
}

constexpr int TR_LDS = 64 * 65 * 4;
struct TrDesc { const float* src; bf16_t* dst; const float* kscale; int ldw, ncols, ldk; };
struct TrRegs { f32x4 v[16]; float ks; };
__device__ __forceinline__ void tr_load(const TrDesc& d, TrRegs& R, int lane) {
    const int r4 = lane >> 4, cq = lane & 15;
    const bool on = 4 * cq < d.ncols;
    const float* sp = d.src + (size_t)r4 * d.ldw + (on ? 4 * cq : 0);
#pragma unroll
    for (int it = 0; it < 16; ++it) { const f32x4 x = *(const f32x4*)(sp + (size_t)(4 * it) * d.ldw); R.v[it] = on ? x : (f32x4){0.f, 0.f, 0.f, 0.f}; }
    R.ks = d.kscale ? d.kscale[lane] : 1.0f;
}
__device__ __forceinline__ void tr_finish(const TrDesc& d, const TrRegs& R, LAS float* scr, int lane, bool valid) {
    const int r4 = lane >> 4, cq = lane & 15;
#pragma unroll
    for (int it = 0; it < 16; ++it) { const int kk = 4 * it + r4; const float kv = __shfl(R.ks, kk); const f32x4 v = R.v[it] * kv;
        LAS float* q = scr + kk * 65 + 4 * cq; q[0] = v[0]; q[1] = v[1]; q[2] = v[2]; q[3] = v[3]; }
    LDS_WAIT(); asm volatile("" ::: "memory");
    const int cc = lane & 7;
#pragma unroll
    for (int j = 0; j < 8; ++j) { const int n = (lane >> 3) + 8 * j; const LAS float* sp = scr + (8 * cc) * 65 + n;
        u32x4 o; o.x = cvt_pk_bf16(sp[0 * 65], sp[1 * 65]); o.y = cvt_pk_bf16(sp[2 * 65], sp[3 * 65]); o.z = cvt_pk_bf16(sp[4 * 65], sp[5 * 65]); o.w = cvt_pk_bf16(sp[6 * 65], sp[7 * 65]);
        if (valid) *(u32x4*)(d.dst + (size_t)n * d.ldk + 8 * cc) = o; }
    LDS_WAIT(); asm volatile("" ::: "memory");
}
constexpr int EARLY_ITEMS = 148 * 32 + 32 * 16 + 32 * 16;
__device__ __forceinline__ TrDesc early_desc(const Params& p, int r) {
    unsigned char* ws = p.ws; TrDesc d; d.kscale = nullptr;
    constexpr int I_IN = 148 * 32, I_A = 32 * 16;
    if (r < I_IN) { const int rb = r / 32, kb = r % 32, dst = rb * 64; int src, nc;
        if (dst < 9216) { src = dst + (dst >= 4096 ? 16 : 0); nc = 64; } else if (dst == 9216) { src = 4096; nc = 16; } else { src = 0; nc = 0; }
        d.src = p.w_in + (size_t)(kb * 64) * 9232 + src; d.ldw = 9232; d.ncols = nc; d.dst = (bf16_t*)(ws + WS_WIN) + (size_t)dst * 2048 + kb * 64; d.ldk = 2048; return d; }
    r -= I_IN;
    const bool isb = r >= I_A; if (isb) r -= I_A;
    const int rb = r / 16, kb = r % 16;
    d.src = (isb ? p.w_proj_b : p.w_proj_a) + (size_t)(kb * 64) * 2048 + rb * 64; d.ldw = 2048; d.ncols = 64; d.dst = (bf16_t*)(ws + (isb ? WS_WB : WS_WA)) + (size_t)(rb * 64) * 1024 + kb * 64; d.ldk = 1024; return d;
}
constexpr int LATE_ITEMS = 32 * 32 + 2 * 88 * 32 + 32 * 88;
__device__ __forceinline__ TrDesc late_desc(const Params& p, int r) {
    unsigned char* ws = p.ws; TrDesc d; d.kscale = nullptr;
    constexpr int I_O = 32 * 32, I_G = 88 * 32;
    if (r < I_O) { const int rb = r / 32, kb = r % 32; d.src = p.w_out + (size_t)(kb * 64) * 2048 + rb * 64; d.ldw = 2048; d.ncols = 64; d.dst = (bf16_t*)(ws + WS_WOUT) + (size_t)(rb * 64) * 2048 + kb * 64; d.ldk = 2048; return d; }
    r -= I_O;
    if (r < 2 * I_G) { const bool up = r >= I_G; if (up) r -= I_G; const int rb = r / 32, kb = r % 32, j0 = rb * 64; const int dst = (j0 / 128) * 256 + (j0 % 128) + (up ? 128 : 0);
        d.src = (up ? p.w_up : p.w_gate) + (size_t)(kb * 64) * FFN + j0; d.ldw = FFN; d.ncols = 64; d.dst = (bf16_t*)(ws + WS_WGU) + (size_t)dst * 2048 + kb * 64; d.ldk = 2048; d.kscale = p.norm_ffn_w + kb * 64; return d; }
    r -= 2 * I_G;
    { const int rb = r / 88, kb = r % 88; d.src = p.w_down + (size_t)(kb * 64) * 2048 + rb * 64; d.ldw = 2048; d.ncols = 64; d.dst = (bf16_t*)(ws + WS_WD) + (size_t)(rb * 64) * FFN + kb * 64; d.ldk = FFN; return d; }
}
template <bool LATE>
__device__ __forceinline__ void convert_weights(const Params& p, LAS unsigned char* lds, int wv, int lane, int wg0, int nwg) {
    LAS float* scr = (LAS float*)(lds + wv * TR_LDS);
    const int gw = ((int)blockIdx.x - wg0) * 8 + wv, NGW = nwg * 8;
    constexpr int NI = LATE ? LATE_ITEMS : EARLY_ITEMS;
    const int trips = (NI + NGW - 1) / NGW;
#define TR_DESC(i_) (LATE ? late_desc(p, (i_) < NI ? (i_) : NI - 1) : early_desc(p, (i_) < NI ? (i_) : NI - 1))
    TrDesc d0 = TR_DESC(gw), d1 = TR_DESC(gw + NGW);
    TrRegs r0, r1;
    tr_load(d0, r0, lane); tr_load(d1, r1, lane);
    for (int k = 0; k < trips; k += 2) {
        const int i0 = gw + k * NGW, i1 = i0 + NGW;
        tr_finish(d0, r0, scr, lane, i0 < NI);
        d0 = TR_DESC(i0 + 2 * NGW); tr_load(d0, r0, lane);
        tr_finish(d1, r1, scr, lane, (k + 1 < trips) && i1 < NI);
        d1 = TR_DESC(i1 + 2 * NGW); tr_load(d1, r1, lane);
    }
#undef TR_DESC
}

__device__ __forceinline__ void phase0(const Params& p, LAS unsigned char* lds, int wv, int lane) {
    unsigned char* ws = p.ws;
    const int gw = blockIdx.x * 8 + wv, NGW = gridDim.x * 8;
    convert_weights<false>(p, lds, wv, lane, 0, (int)gridDim.x);
    { bf16_t* PB = (bf16_t*)(ws + WS_POOLT);
      for (int i = blockIdx.x * NTHREADS + threadIdx.x; i < 4 * 256 * 256 / 4; i += gridDim.x * NTHREADS) {
          const int e = 4 * i, g = e >> 16, d = e & 255; const f32x4 v = *(const f32x4*)(p.pool_w + e); const f32x4 sc = *(const f32x4*)(p.pool_scale + g * 256 + d);
          u32x2 o; o.x = cvt_pk_bf16(v[0] * sc[0], v[1] * sc[1]); o.y = cvt_pk_bf16(v[2] * sc[2], v[3] * sc[3]); *(u32x2*)(PB + e) = o; } }
    bf16_t* HN = (bf16_t*)(ws + WS_HN);
    for (int row = gw; row < RP; row += NGW) {
        const float* src = nullptr;
        if (row < RPV) { const int b = row / TB, pos = row - b * TB; if (pos >= 64) src = p.x + (size_t)(b * SEQ + pos - 64) * D; else if (pos >= 48) src = p.meta + (size_t)(pos - 48) * D; }
        u32x2* o8 = (u32x2*)(HN + (size_t)row * D) + lane;
        if (!src) {
#pragma unroll
            for (int j = 0; j < 8; ++j) o8[64 * j] = (u32x2){0u, 0u};
        } else {
            const f32x4* xr = (const f32x4*)src + lane; const f32x4* wr_ = (const f32x4*)p.norm_mix_w + lane;
            f32x4 v[8]; float s = 0.f;
#pragma unroll
            for (int j = 0; j < 8; ++j) { v[j] = xr[64 * j]; s += (v[j][0] * v[j][0] + v[j][1] * v[j][1]) + (v[j][2] * v[j][2] + v[j][3] * v[j][3]); }
            const float rstd = __builtin_amdgcn_rsqf(wave_sum(s) * (1.0f / D) + RMS_EPS);
#pragma unroll
            for (int j = 0; j < 8; ++j) { const f32x4 w = wr_[64 * j]; u32x2 o; o.x = cvt_pk_bf16(v[j][0] * rstd * w[0], v[j][1] * rstd * w[1]); o.y = cvt_pk_bf16(v[j][2] * rstd * w[2], v[j][3] * rstd * w[3]); o8[64 * j] = o; }
        }
    }
}

__device__ __forceinline__ void prep_phase(const Params& p, LAS unsigned char* lds, int wv, int lane_in, int n_lo, int n_hi, int w, int nw) {
    unsigned char* ws = p.ws;
    LAS float* AM = (LAS float*)(lds);
    LAS bf16_t* TM = (LAS bf16_t*)(lds + 17408);
    LAS bf16_t* QN = (LAS bf16_t*)(lds + 26624);
    LAS bf16_t* KN = (LAS bf16_t*)(lds + 44032);
    LAS bf16_t* KBT = (LAS bf16_t*)(lds + 61440);
    LAS bf16_t* VBT = (LAS bf16_t*)(lds + 79872);
    const bf16_t* QKV = (const bf16_t*)(ws + WS_QKV); const float* BA = (const float*)(ws + WS_BA); float* GL = (float*)(ws + WS_GL);
    const float qscale = 0.08838834764831845f;
    for (int ui = w; ui < (n_hi - n_lo) * 16; ui += nw) {
        const int n = n_lo + (ui >> 4), b = (ui >> 3) & 1, h = ui & 7;
        const int r0 = b * TB + n * 64;
        int lane = lane_in; asm volatile("" : "+v"(lane));
        const int fr = lane & 15, fq = lane >> 4;
        const int urec = (b * NH + h) * NCH + n;
        bf16_t* UA = (bf16_t*)p.out + (size_t)urec * 24576; bf16_t* UB = (bf16_t*)(ws + WS_PREPB) + (size_t)urec * 12288;
        bf16_t* uT = UA; bf16_t* wM = UA + 8192; bf16_t* qd = UA + 16384; bf16_t* kdT = UB; bf16_t* qkM = UB + 8192;
        float beta, gc, gcl;
        { const float bl = BA[(size_t)(r0 + lane) * 16 + h], al = BA[(size_t)(r0 + lane) * 16 + 8 + h];
          const bool valid = !(n == 0 && lane < 48);
          const float xg = al + p.dt_bias[h]; const float sp = fmaxf(xg, 0.f) + log1pf(expf(-fabsf(xg)));
          float g = valid ? -expf(p.a_log[h]) * sp : 0.f;
          beta = valid ? 1.0f / (1.0f + expf(-bl)) : 0.f;
#pragma unroll
          for (int o = 1; o < 64; o <<= 1) { const float t = __shfl_up(g, o); if (lane >= o) g += t; }
          gc = g; gcl = __shfl(gc, 63); }
        {
            const int t0 = wv * 8;
            unsigned xin[3][11]; float cw[3][4][2];
#pragma unroll
            for (int c3 = 0; c3 < 3; ++c3) {
#pragma unroll
                for (int i = 0; i < 11; ++i) { const int grow = r0 + t0 - 3 + i; xin[c3][i] = (grow >= 0) ? *(const unsigned*)(QKV + (size_t)grow * 3072 + c3 * 1024 + h * 128 + 2 * lane) : 0u; }
#pragma unroll
                for (int j = 0; j < 4; ++j) { const f32x2 w2 = *(const f32x2*)(p.conv_w + (size_t)j * 3072 + c3 * 1024 + h * 128 + 2 * lane); cw[c3][j][0] = w2[0]; cw[c3][j][1] = w2[1]; }
            }
            float kb[2][8], vb[2][8], kd[2][8];
            float y[8][3][2], ssq[8], ssk[8];
#pragma unroll
            for (int i = 0; i < 8; ++i) {
#pragma unroll
                for (int c3 = 0; c3 < 3; ++c3) { float a0 = 0.f, a1 = 0.f;
#pragma unroll
                    for (int j = 0; j < 4; ++j) { a0 += cw[c3][j][0] * bf_lo(xin[c3][i + j]); a1 += cw[c3][j][1] * bf_hi(xin[c3][i + j]); }
                    y[i][c3][0] = fast_silu(a0); y[i][c3][1] = fast_silu(a1); }
                ssq[i] = y[i][0][0] * y[i][0][0] + y[i][0][1] * y[i][0][1]; ssk[i] = y[i][1][0] * y[i][1][0] + y[i][1][1] * y[i][1][1];
            }
#pragma unroll
            for (int o = 1; o < 64; o <<= 1) {
#pragma unroll
                for (int i = 0; i < 8; ++i) { ssq[i] += __shfl_xor(ssq[i], o); ssk[i] += __shfl_xor(ssk[i], o); }
            }
#pragma unroll
            for (int i = 0; i < 8; ++i) {
                const int t = t0 + i;
                const float rq = __builtin_amdgcn_rsqf(ssq[i] + L2_EPS) * qscale, rk = __builtin_amdgcn_rsqf(ssk[i] + L2_EPS);
                const float bt = __shfl(beta, t), gct = __shfl(gc, t);
                const float eg = __expf(gct), egl = __expf(gcl - gct);
                const float q0 = y[i][0][0] * rq, q1 = y[i][0][1] * rq, k0 = y[i][1][0] * rk, k1 = y[i][1][1] * rk;
                *(LAS unsigned*)(QN + t * 136 + 2 * lane) = cvt_pk_bf16(q0, q1);
                *(LAS unsigned*)(KN + t * 136 + 2 * lane) = cvt_pk_bf16(k0, k1);
                *(unsigned*)(qd + ((((t >> 4) * 4 + (lane >> 4)) * 64 + ((lane & 15) >> 2) * 16 + (t & 15)) * 8 + 2 * (lane & 3))) = cvt_pk_bf16(q0 * eg, q1 * eg);
                kb[0][i] = k0 * bt * eg; kb[1][i] = k1 * bt * eg; vb[0][i] = y[i][2][0] * bt; vb[1][i] = y[i][2][1] * bt; kd[0][i] = k0 * egl; kd[1][i] = k1 * egl;
            }
#pragma unroll
            for (int ch = 0; ch < 2; ++ch) { const int d = 2 * lane + ch; u32x4 a, v, k;
                a.x = cvt_pk_bf16(kb[ch][0], kb[ch][1]); a.y = cvt_pk_bf16(kb[ch][2], kb[ch][3]); a.z = cvt_pk_bf16(kb[ch][4], kb[ch][5]); a.w = cvt_pk_bf16(kb[ch][6], kb[ch][7]);
                v.x = cvt_pk_bf16(vb[ch][0], vb[ch][1]); v.y = cvt_pk_bf16(vb[ch][2], vb[ch][3]); v.z = cvt_pk_bf16(vb[ch][4], vb[ch][5]); v.w = cvt_pk_bf16(vb[ch][6], vb[ch][7]);
                k.x = cvt_pk_bf16(kd[ch][0], kd[ch][1]); k.y = cvt_pk_bf16(kd[ch][2], kd[ch][3]); k.z = cvt_pk_bf16(kd[ch][4], kd[ch][5]); k.w = cvt_pk_bf16(kd[ch][6], kd[ch][7]);
                *(LAS u32x4*)(KBT + d * 72 + t0) = a; *(LAS u32x4*)(VBT + d * 72 + t0) = v;
                *(u32x4*)(kdT + ((((d >> 4) * 2 + (wv >> 2)) * 64 + (wv & 3) * 16 + (d & 15)) * 8)) = k; }
        }
        __syncthreads();
        {
            const int it = wv >> 1;
#pragma unroll
            for (int jj = 0; jj < 2; ++jj) { const int jt = (wv & 1) * 2 + jj;
                f32x4 akk = (f32x4){0.f, 0.f, 0.f, 0.f}, aqk = (f32x4){0.f, 0.f, 0.f, 0.f};
#pragma unroll
                for (int kk = 0; kk < 4; ++kk) {
                    const bf16x8 kni = *(const LAS bf16x8*)(KN + (it * 16 + fr) * 136 + kk * 32 + fq * 8);
                    const bf16x8 knj = *(const LAS bf16x8*)(KN + (jt * 16 + fr) * 136 + kk * 32 + fq * 8);
                    const bf16x8 qni = *(const LAS bf16x8*)(QN + (it * 16 + fr) * 136 + kk * 32 + fq * 8);
                    akk = __builtin_amdgcn_mfma_f32_16x16x32_bf16(kni, knj, akk, 0, 0, 0);
                    aqk = __builtin_amdgcn_mfma_f32_16x16x32_bf16(knj, qni, aqk, 0, 0, 0);
                }
                { const int j = jt * 16 + fr; const float gj = __shfl(gc, j);
#pragma unroll
                  for (int r = 0; r < 4; ++r) { const int i = it * 16 + fq * 4 + r; const float gi = __shfl(gc, i), bi = __shfl(beta, i);
                      AM[i * 68 + j] = (j < i) ? bi * akk[r] * expf(gi - gj) : 0.f; } }
                { const int i = it * 16 + fr; const float gi = __shfl(gc, i); float v[4];
#pragma unroll
                  for (int r = 0; r < 4; ++r) { const int j = jt * 16 + fq * 4 + r; const float gj = __shfl(gc, j); v[r] = (j <= i) ? aqk[r] * expf(gi - gj) : 0.f; }
                  u32x2 w; w.x = cvt_pk_bf16(v[0], v[1]); w.y = cvt_pk_bf16(v[2], v[3]);
                  *(u32x2*)(qkM + (((it * 2 + (jt >> 1)) * 64 + ((jt & 1) * 2 + (fq >> 1)) * 16 + fr) * 8 + (fq & 1) * 4)) = w; }
            }
        }
        __syncthreads();
        {
            LAS bf16_t* T11T = (LAS bf16_t*)(lds + 98304);
            LAS bf16_t* A21B = (LAS bf16_t*)(lds + 100864);
            LAS bf16_t* XT = (LAS bf16_t*)(lds + 103424);
            if (wv < 2) {
                const int o = wv * 32, c = lane & 31;
                float t[32];
#pragma unroll
                for (int i = 0; i < 32; ++i) {
                    float a0 = (c == i) ? 1.f : 0.f, a1 = 0.f, a2 = 0.f, a3 = 0.f;
#pragma unroll
                    for (int j = 0; j < (i & ~3); j += 4) { const f32x4 av = *(const LAS f32x4*)(AM + (o + i) * 68 + o + j); a0 -= av[0] * t[j]; a1 -= av[1] * t[j + 1]; a2 -= av[2] * t[j + 2]; a3 -= av[3] * t[j + 3]; }
#pragma unroll
                    for (int j = (i & ~3); j < i; ++j) a0 -= AM[(o + i) * 68 + o + j] * t[j];
                    t[i] = (a0 + a1) + (a2 + a3);
                    if (lane < 32) TM[(o + i) * 72 + o + c] = (bf16_t)(cvt_pk_bf16(t[i], 0.f) & 0xffffu);
                    else if (wv == 0) TM[i * 72 + lane] = (bf16_t)0;
                    asm volatile("" ::: "memory");
                }
                if (wv == 0 && lane < 32) {
#pragma unroll
                    for (int q = 0; q < 4; ++q) { u32x4 w; w.x = cvt_pk_bf16(t[8 * q], t[8 * q + 1]); w.y = cvt_pk_bf16(t[8 * q + 2], t[8 * q + 3]); w.z = cvt_pk_bf16(t[8 * q + 4], t[8 * q + 5]); w.w = cvt_pk_bf16(t[8 * q + 6], t[8 * q + 7]);
                        *(LAS u32x4*)(T11T + c * 40 + 8 * q) = w; }
                }
                if (wv == 0 && lane == 0) GL[urec] = expf(gcl);
            } else if (wv < 6) {
                const int e = (wv - 2) * 256 + lane * 4, i = e >> 5, k = e & 31;
                const f32x4 v = *(const LAS f32x4*)(AM + (32 + i) * 68 + k);
                u32x2 w; w.x = cvt_pk_bf16(v[0], v[1]); w.y = cvt_pk_bf16(v[2], v[3]);
                *(LAS u32x2*)(A21B + i * 40 + k) = w;
            }
            __syncthreads();
            const int it2 = (wv >> 1) & 1, jt2 = wv & 1;
            if (wv < 4) {
                const bf16x8 xa = *(const LAS bf16x8*)(A21B + (it2 * 16 + fr) * 40 + fq * 8);
                const bf16x8 yb = *(const LAS bf16x8*)(T11T + (jt2 * 16 + fr) * 40 + fq * 8);
                const f32x4 x = __builtin_amdgcn_mfma_f32_16x16x32_bf16(xa, yb, (f32x4){0.f, 0.f, 0.f, 0.f}, 0, 0, 0);
                u32x2 w; w.x = cvt_pk_bf16(x[0], x[1]); w.y = cvt_pk_bf16(x[2], x[3]);
                *(LAS u32x2*)(XT + (jt2 * 16 + fr) * 40 + it2 * 16 + fq * 4) = w;
            }
            __syncthreads();
            if (wv < 4) {
                const bf16x8 ta = *(const LAS bf16x8*)(TM + (32 + it2 * 16 + fr) * 72 + 32 + fq * 8);
                const bf16x8 xb = *(const LAS bf16x8*)(XT + (jt2 * 16 + fr) * 40 + fq * 8);
                const f32x4 r = __builtin_amdgcn_mfma_f32_16x16x32_bf16(ta, xb, (f32x4){0.f, 0.f, 0.f, 0.f}, 0, 0, 0);
#pragma unroll
                for (int q = 0; q < 4; ++q) TM[(32 + it2 * 16 + fq * 4 + q) * 72 + jt2 * 16 + fr] = (bf16_t)(cvt_pk_bf16(-r[q], 0.f) & 0xffffu);
            }
        }
        __syncthreads();
        {
#pragma unroll
            for (int ct = 0; ct < 4; ++ct) {
                f32x4 au = (f32x4){0.f, 0.f, 0.f, 0.f}, aw = (f32x4){0.f, 0.f, 0.f, 0.f};
#pragma unroll
                for (int kk = 0; kk < 2; ++kk) {
                    const bf16x8 tf = *(const LAS bf16x8*)(TM + (ct * 16 + fr) * 72 + kk * 32 + fq * 8);
                    const bf16x8 vf = *(const LAS bf16x8*)(VBT + (wv * 16 + fr) * 72 + kk * 32 + fq * 8);
                    const bf16x8 kf = *(const LAS bf16x8*)(KBT + (wv * 16 + fr) * 72 + kk * 32 + fq * 8);
                    au = __builtin_amdgcn_mfma_f32_16x16x32_bf16(tf, vf, au, 0, 0, 0);
                    aw = __builtin_amdgcn_mfma_f32_16x16x32_bf16(kf, tf, aw, 0, 0, 0);
                }
                u32x2 w1; w1.x = cvt_pk_bf16(au[0], au[1]); w1.y = cvt_pk_bf16(au[2], au[3]);
                *(u32x2*)(uT + ((wv * 4 + ct) * 64 + lane) * 4) = w1;
                u32x2 w2; w2.x = cvt_pk_bf16(aw[0], aw[1]); w2.y = cvt_pk_bf16(aw[2], aw[3]);
                *(u32x2*)(wM + (((ct * 4 + (wv >> 1)) * 64 + ((wv & 1) * 2 + (fq >> 1)) * 16 + fr) * 8 + (fq & 1) * 4)) = w2;
            }
        }
        __syncthreads();
    }
}

struct ScanRegs { bf16x8 X[4]; bf16x8 Y[2]; bf16x8 KD[2]; u32x2 UU; float gl; };
__device__ __forceinline__ void scan_load(ScanRegs& R, const bf16_t* baseA, const bf16_t* baseB, const float* GL, int unit, int es, int ct, bool roleB, int dt, int lane) {
    const bf16_t* xb = baseA + (roleB ? 16384 : 8192);
#pragma unroll
    for (int kk = 0; kk < 4; ++kk) R.X[kk] = *(const bf16x8*)(xb + ((ct * 4 + kk) * 64 + lane) * 8);
#pragma unroll
    for (int kk = 0; kk < 2; ++kk) R.KD[kk] = *(const bf16x8*)(baseB + ((dt * 2 + kk) * 64 + lane) * 8);
#pragma unroll
    for (int kk = 0; kk < 2; ++kk) R.Y[kk] = *(const bf16x8*)(baseB + 8192 + (roleB ? ((ct * 2 + kk) * 64 + lane) * 8 : 0));
    R.UU = *(const u32x2*)(baseA + (roleB ? 0 : ((es * 4 + ct) * 64 + lane) * 4));
    R.gl = GL[unit];
}
#define LDS_BARRIER() do { asm volatile("s_waitcnt lgkmcnt(0)" ::: "memory"); __builtin_amdgcn_s_barrier(); asm volatile("" ::: "memory"); } while (0)
__device__ __forceinline__ void scan_step(const ScanRegs& cur, f32x4& sacc, LAS bf16_t* SBc, LAS bf16_t* SBn, LAS bf16_t* VN, bf16_t* Orow  , int ct, bool roleB, int dt, int fr, int fq, int hcol) {
    bf16x8 sbf[4];
#pragma unroll
    for (int kk = 0; kk < 4; ++kk) sbf[kk] = *(const LAS bf16x8*)(SBc + fr * 136 + kk * 32 + fq * 8);
    f32x4 a = (f32x4){0.f, 0.f, 0.f, 0.f};
    if (!roleB) {
#pragma unroll
        for (int kk = 0; kk < 4; ++kk) a = __builtin_amdgcn_mfma_f32_16x16x32_bf16(cur.X[kk], sbf[kk], a, 0, 0, 0);
        const float v0 = bf_lo(cur.UU.x) - a[0], v1 = bf_hi(cur.UU.x) - a[1], v2 = bf_lo(cur.UU.y) - a[2], v3 = bf_hi(cur.UU.y) - a[3];
        u32x2 w; w.x = cvt_pk_bf16(v0, v1); w.y = cvt_pk_bf16(v2, v3);
        *(LAS u32x2*)(VN + fr * 72 + ct * 16 + fq * 4) = w;
    } else {
#pragma unroll
        for (int kk = 0; kk < 4; ++kk) a = __builtin_amdgcn_mfma_f32_16x16x32_bf16(sbf[kk], cur.X[kk], a, 0, 0, 0);
    }
    LDS_BARRIER();
    bf16x8 vnf[2];
#pragma unroll
    for (int kk = 0; kk < 2; ++kk) vnf[kk] = *(const LAS bf16x8*)(VN + fr * 72 + kk * 32 + fq * 8);
    sacc = sacc * cur.gl;
#pragma unroll
    for (int kk = 0; kk < 2; ++kk) sacc = __builtin_amdgcn_mfma_f32_16x16x32_bf16(cur.KD[kk], vnf[kk], sacc, 0, 0, 0);
    { u32x2 w; w.x = cvt_pk_bf16(sacc[0], sacc[1]); w.y = cvt_pk_bf16(sacc[2], sacc[3]);
      *(LAS u32x2*)(SBn + fr * 136 + dt * 16 + fq * 4) = w; }
    if (roleB) {
#pragma unroll
        for (int kk = 0; kk < 2; ++kk) a = __builtin_amdgcn_mfma_f32_16x16x32_bf16(vnf[kk], cur.Y[kk], a, 0, 0, 0);
        u32x2 w; w.x = cvt_pk_bf16(a[0], a[1]); w.y = cvt_pk_bf16(a[2], a[3]);
        *(u32x2*)(Orow + (size_t)(ct * 16 + fr) * 1024 + hcol + fq * 4) = w;
    }
    LDS_BARRIER();
}
__device__ __forceinline__ void scan_run(const Params& p, LAS unsigned char* lds, int wv, int lane, f32x4& sacc, int n_lo, int n_hi, bool init) {
    unsigned char* ws = p.ws;
    const int tid = threadIdx.x, fr = lane & 15, fq = lane >> 4;
    const int xcd_ = blockIdx.x & 7, j_ = blockIdx.x >> 3, bh_ = xcd_ * 2 + (j_ >> 3);
    const int b = bh_ >> 3, h = bh_ & 7, es = j_ & 7, e0 = es * 16;
    const int ct = wv & 3, dt = wv; const bool roleB = wv >= 4;
    LAS bf16_t* SB = (LAS bf16_t*)lds;
    LAS bf16_t* VN = (LAS bf16_t*)(lds + 8704);
    const bf16_t* PREPA = (const bf16_t*)p.out; const bf16_t* PREPB = (const bf16_t*)(ws + WS_PREPB); const float* GL = (const float*)(ws + WS_GL); bf16_t* O = (bf16_t*)(ws + WS_O);
    if (init) {
        for (int i = tid; i < 2 * 16 * 136 / 2; i += NTHREADS) ((LAS unsigned*)SB)[i] = 0u;
        __syncthreads();
        sacc = (f32x4){0.f, 0.f, 0.f, 0.f};
    }
    const int ubase = (b * NH + h) * NCH;
    const int hcol = h * 128 + e0;
    bf16_t* Ob = O + (size_t)(b * TB) * 1024;
#define SCAN_LOAD(R, n_) do { const int nn_ = (n_) < n_hi ? (n_) : n_hi - 1; const int unit_ = ubase + nn_; scan_load(R, PREPA + (size_t)unit_ * 24576, PREPB + (size_t)unit_ * 12288, GL, unit_, es, ct, roleB, dt, lane); } while (0)
#define SCAN_STEP(R, n_, SBr, SBw) scan_step(R, sacc, SBr, SBw, VN, Ob + (size_t)((n_) * 64) * 1024, ct, roleB, dt, fr, fq, hcol)
    ScanRegs r0, r1, r2, r3;
    SCAN_LOAD(r0, n_lo); SCAN_LOAD(r1, n_lo + 1); SCAN_LOAD(r2, n_lo + 2);
    LAS bf16_t* SB0 = SB; LAS bf16_t* SB1 = SB + 2176;
    for (int n = n_lo; n < n_hi; n += 4) {
        SCAN_LOAD(r3, n + 3); SCAN_STEP(r0, n, SB0, SB1);
        SCAN_LOAD(r0, n + 4); if (n + 1 < n_hi) SCAN_STEP(r1, n + 1, SB1, SB0);
        SCAN_LOAD(r1, n + 5); if (n + 2 < n_hi) SCAN_STEP(r2, n + 2, SB0, SB1);
        SCAN_LOAD(r2, n + 6); if (n + 3 < n_hi) SCAN_STEP(r3, n + 3, SB1, SB0);
    }
#undef SCAN_LOAD
#undef SCAN_STEP
    asm volatile("s_waitcnt vmcnt(0)" ::: "memory");
    __syncthreads();
}

template <int WIN>
__device__ __forceinline__ void pooled_item(const Params& p, int it, int lane) {
    const bf16_t* P = (const bf16_t*)(p.ws + WS_P); bf16_t* PO = (bf16_t*)(p.ws + WS_POOLED);
    const int rb = it >> 3, cb = it & 7;
    const int rr0 = rb * 16, prow0 = rr0 + 64 + ((rr0 >> 13) << 6);
    const int col = cb * 128 + 2 * lane;
    float v0[15 + WIN], v1[15 + WIN];
#pragma unroll
    for (int k = 0; k < 15 + WIN; ++k) { const unsigned w = *(const unsigned*)(P + (size_t)(prow0 - (WIN - 1) + k) * 1024 + col); v0[k] = bf_lo(w); v1[k] = bf_hi(w); }
    const float inv = 1.0f / (float)WIN;
#pragma unroll
    for (int i = 0; i < 16; ++i) { float a0 = 0.f, a1 = 0.f;
#pragma unroll
        for (int s2 = 0; s2 < WIN; ++s2) { a0 += v0[WIN - 1 + i - s2]; a1 += v1[WIN - 1 + i - s2]; }
        *(unsigned*)(PO + (size_t)(rr0 + i) * 1024 + col) = cvt_pk_bf16(a0 * inv - v0[WIN - 1 + i], a1 * inv - v1[WIN - 1 + i]); }
}

__device__ __forceinline__ void phase4(const Params& p, LAS unsigned char* lds, int wv, int lane) {
    unsigned char* ws = p.ws;
    const int gw = blockIdx.x * 8 + wv, NGW = gridDim.x * 8;
    { const bf16_t* O = (const bf16_t*)(ws + WS_O); const bf16_t* Z = (const bf16_t*)(ws + WS_Z); bf16_t* OG = (bf16_t*)(ws + WS_OG);
      f32x4 nw[4];
#pragma unroll
      for (int i = 0; i < 4; ++i) nw[i] = *(const f32x4*)(p.o_norm_w + (lane & 7) * 16 + 4 * i);
      for (int rr = gw; rr < RR; rr += NGW) {
          const int prow = rr + 64 + ((rr >> 13) << 6);
          const u32x4 o0 = *(const u32x4*)(O + (size_t)prow * 1024 + lane * 16), o1 = *(const u32x4*)(O + (size_t)prow * 1024 + lane * 16 + 8);
          const u32x4 z0 = *(const u32x4*)(Z + (size_t)prow * 1024 + lane * 16), z1 = *(const u32x4*)(Z + (size_t)prow * 1024 + lane * 16 + 8);
          float ov[16], zv[16];
          ov[0] = bf_lo(o0.x); ov[1] = bf_hi(o0.x); ov[2] = bf_lo(o0.y); ov[3] = bf_hi(o0.y); ov[4] = bf_lo(o0.z); ov[5] = bf_hi(o0.z); ov[6] = bf_lo(o0.w); ov[7] = bf_hi(o0.w);
          ov[8] = bf_lo(o1.x); ov[9] = bf_hi(o1.x); ov[10] = bf_lo(o1.y); ov[11] = bf_hi(o1.y); ov[12] = bf_lo(o1.z); ov[13] = bf_hi(o1.z); ov[14] = bf_lo(o1.w); ov[15] = bf_hi(o1.w);
          zv[0] = bf_lo(z0.x); zv[1] = bf_hi(z0.x); zv[2] = bf_lo(z0.y); zv[3] = bf_hi(z0.y); zv[4] = bf_lo(z0.z); zv[5] = bf_hi(z0.z); zv[6] = bf_lo(z0.w); zv[7] = bf_hi(z0.w);
          zv[8] = bf_lo(z1.x); zv[9] = bf_hi(z1.x); zv[10] = bf_lo(z1.y); zv[11] = bf_hi(z1.y); zv[12] = bf_lo(z1.z); zv[13] = bf_hi(z1.z); zv[14] = bf_lo(z1.w); zv[15] = bf_hi(z1.w);
          float ss = 0.f;
#pragma unroll
          for (int i = 0; i < 16; ++i) ss += ov[i] * ov[i];
          ss += __shfl_xor(ss, 1); ss += __shfl_xor(ss, 2); ss += __shfl_xor(ss, 4);
          const float rstd = __builtin_amdgcn_rsqf(ss * (1.0f / 128.0f) + RMS_EPS);
          float r[16];
#pragma unroll
          for (int i = 0; i < 16; ++i) r[i] = ov[i] * rstd * nw[i >> 2][i & 3] * zv[i];
          u32x4 w0, w1; w0.x = cvt_pk_bf16(r[0], r[1]); w0.y = cvt_pk_bf16(r[2], r[3]); w0.z = cvt_pk_bf16(r[4], r[5]); w0.w = cvt_pk_bf16(r[6], r[7]);
          w1.x = cvt_pk_bf16(r[8], r[9]); w1.y = cvt_pk_bf16(r[10], r[11]); w1.z = cvt_pk_bf16(r[12], r[13]); w1.w = cvt_pk_bf16(r[14], r[15]);
          *(u32x4*)(OG + (size_t)rr * 1024 + lane * 16) = w0; *(u32x4*)(OG + (size_t)rr * 1024 + lane * 16 + 8) = w1;
      } }
    for (int it = gw; it < 1024 * 8; it += NGW) {
        const int g = (it & 7) >> 1;
        if (g == 0) pooled_item<2>(p, it, lane); else if (g == 1) pooled_item<4>(p, it, lane); else if (g == 2) pooled_item<8>(p, it, lane); else pooled_item<16>(p, it, lane);
    }
}

__device__ __forceinline__ void final_phase(const Params& p, int wv, int lane, int row_lo, int row_hi, int w, int nw) {
    const int gw = row_lo + w, NGW = nw; const int RRH = row_hi;
    const bf16_t* H2B = (const bf16_t*)(p.ws + WS_H2B);
    for (int rr = gw; rr < RRH; rr += NGW) {
        const u32x4* hr = (const u32x4*)(H2B + (size_t)rr * D) + lane;
        u32x4 h[4]; float s = 0.f;
#pragma unroll
        for (int j = 0; j < 4; ++j) { h[j] = hr[64 * j];
            const float f0 = bf_lo(h[j].x), f1 = bf_hi(h[j].x), f2 = bf_lo(h[j].y), f3 = bf_hi(h[j].y), f4 = bf_lo(h[j].z), f5 = bf_hi(h[j].z), f6 = bf_lo(h[j].w), f7 = bf_hi(h[j].w);
            s += ((f0 * f0 + f1 * f1) + (f2 * f2 + f3 * f3)) + ((f4 * f4 + f5 * f5) + (f6 * f6 + f7 * f7)); }
        const float rstd = __builtin_amdgcn_rsqf(wave_sum(s) * (1.0f / D) + RMS_EPS);
#pragma unroll
        for (int j = 0; j < 4; ++j) { const int e = 8 * (lane + 64 * j); const f32x4 w0 = *(const f32x4*)(p.norm_final_w + e), w1 = *(const f32x4*)(p.norm_final_w + e + 4);
            f32x4 o0, o1; o0[0] = bf_lo(h[j].x) * rstd * w0[0]; o0[1] = bf_hi(h[j].x) * rstd * w0[1]; o0[2] = bf_lo(h[j].y) * rstd * w0[2]; o0[3] = bf_hi(h[j].y) * rstd * w0[3];
            o1[0] = bf_lo(h[j].z) * rstd * w1[0]; o1[1] = bf_hi(h[j].z) * rstd * w1[1]; o1[2] = bf_lo(h[j].w) * rstd * w1[2]; o1[3] = bf_hi(h[j].w) * rstd * w1[3];
            *(f32x4*)(p.out + (size_t)rr * D + e) = o0; *(f32x4*)(p.out + (size_t)rr * D + e + 4) = o1; }
    }
}

#define XB_TMO      128
#define XB_XCNT(j)  (256  + 64 * (j))
#define XB_XSUB(j)  (1280 + 64 * (j))
#define XB_XGEN(j)  (2304 + 64 * (j))
#define XB_TOP      3328
#define XB_TOPGEN   3392
#define XCD_BAR_WORDS 3456
#define XB_SPIN_CAP (1u << 22)
__device__ __forceinline__ unsigned xb_ld(unsigned* p)              { return __hip_atomic_load(p, __ATOMIC_RELAXED, __HIP_MEMORY_SCOPE_AGENT); }
__device__ __forceinline__ unsigned xb_add(unsigned* p, unsigned v) { return __hip_atomic_fetch_add(p, v, __ATOMIC_RELAXED, __HIP_MEMORY_SCOPE_AGENT); }
__device__ __forceinline__ unsigned xb_xcc_id() { return (unsigned)__builtin_amdgcn_s_getreg((3 << 11) | 20) & 0xFu; }
#define XB_SPIN(cond, bar) do { unsigned _sp = 0; while (cond) { __builtin_amdgcn_s_sleep(1); \
    if ((++_sp & 255u) == 0u) { if (xb_ld(&(bar)[XB_TMO])) break; if (_sp > XB_SPIN_CAP) { atomicAdd(&(bar)[XB_TMO], 1u); break; } } } } while (0)
struct XcdBarrier { unsigned* bar; unsigned x; volatile LAS unsigned* st; };
__device__ __forceinline__ XcdBarrier xcd_barrier_post(unsigned* bar, volatile LAS unsigned* st) {
    XcdBarrier b; b.bar = bar; b.x = xb_xcc_id(); b.st = st;
    if (threadIdx.x == 0) (void)xb_add(&bar[XB_XCNT(b.x)], 1u);
    return b;
}
__device__ __forceinline__ void xcd_barrier_complete(unsigned* bar, unsigned x, unsigned& nloc, unsigned& nx) {
    const unsigned G = gridDim.x * gridDim.y * gridDim.z;
    unsigned sum, cnt, mine, sp = 0u;
    for (;;) {
        sum = 0u; cnt = 0u; mine = 0u;
#pragma unroll
        for (unsigned j = 0; j < 16; ++j) { const unsigned c = xb_ld(&bar[XB_XCNT(j)]); sum += c; cnt += (c > 0u) ? 1u : 0u; mine = (j == x) ? c : mine; }
        if (sum == G) break;
        __builtin_amdgcn_s_sleep(1);
        if ((++sp & 255u) == 0u) { if (xb_ld(&bar[XB_TMO])) break; if (sp > XB_SPIN_CAP) { atomicAdd(&bar[XB_TMO], 1u); break; } }
    }
    nloc = mine > 0u ? mine : 1u; nx = cnt > 0u ? cnt : 1u;
}
__device__ __forceinline__ void xcd_barrier(const XcdBarrier& b) {
    asm volatile("s_waitcnt vmcnt(0)" ::: "memory");
    __syncthreads();
    if (threadIdx.x == 0) {
        unsigned* bar = b.bar;
        __builtin_amdgcn_s_waitcnt(0);
        unsigned nloc = b.st[0], nx = b.st[1];
        if (nloc == 0u) { xcd_barrier_complete(bar, b.x, nloc, nx); b.st[0] = nloc; b.st[1] = nx; }
        const unsigned old = xb_add(&bar[XB_XSUB(b.x)], 1u);
        const unsigned gen = old / nloc;
        if (old + 1u == (gen + 1u) * nloc) {
            __builtin_amdgcn_fence(__ATOMIC_RELEASE, "agent");
            asm volatile("s_waitcnt vmcnt(0)" ::: "memory");
            const unsigned og = xb_add(&bar[XB_TOP], 1u);
            const unsigned tg = og / nx;
            if (og + 1u == (tg + 1u) * nx) xb_add(&bar[XB_TOPGEN], 1u);
            else XB_SPIN(xb_ld(&bar[XB_TOPGEN]) == tg, bar);
            __builtin_amdgcn_fence(__ATOMIC_ACQUIRE, "agent");
            xb_add(&bar[XB_XGEN(b.x)], 1u);
            asm volatile("s_waitcnt vmcnt(0)" ::: "memory");
        } else {
            XB_SPIN(xb_ld(&bar[XB_XGEN(b.x)]) == gen, bar);
            __builtin_amdgcn_fence(__ATOMIC_ACQUIRE, "agent");
            asm volatile("s_waitcnt vmcnt(0)" ::: "memory");
        }
    }
    __syncthreads();
}

__device__ __forceinline__ void team_barrier(unsigned* ctr  , unsigned& gen, bool same_xcc  ) {
    asm volatile("s_waitcnt vmcnt(0)" ::: "memory");
    __syncthreads();
    ++gen;
    if (threadIdx.x == 0) {
        if (!same_xcc) __builtin_amdgcn_fence(__ATOMIC_RELEASE, "agent");
        asm volatile("s_waitcnt vmcnt(0)" ::: "memory");
        (void)xb_add(ctr, 1u);
        unsigned sp = 0; const unsigned want = 4u * gen;
        while (xb_ld(ctr) < want) { __builtin_amdgcn_s_sleep(1); if (++sp > XB_SPIN_CAP) break; }
        __builtin_amdgcn_fence(__ATOMIC_ACQUIRE, "agent");
        asm volatile("s_waitcnt vmcnt(0)" ::: "memory");
    }
    __syncthreads();
}

__global__ void __launch_bounds__(NTHREADS, 2) fwd_kernel(Params p) {
    extern __shared__ __attribute__((aligned(16))) unsigned char lds_raw[];
    LAS unsigned char* lds = (LAS unsigned char*)lds_raw;
    const int tid = threadIdx.x, wv = __builtin_amdgcn_readfirstlane(tid >> 6), lane = tid & 63;
    unsigned char* ws = p.ws;
    const int lo = (int)p.phase_lo, hi = (int)p.phase_hi;
#ifndef PH_MASK
#define PH_MASK 0x7ff
#endif
#define IN(k) (((PH_MASK >> (k)) & 1) && lo <= (k) && (k) < hi)
#if MK_MULTI
#define SYNC(k) do { } while (0)
#else
    cg::grid_group grid = cg::this_grid();
    volatile LAS unsigned* MISC = (volatile LAS unsigned*)(lds + LDS_BYTES - 256);
    if (tid < 32) MISC[tid] = 0u;
    __syncthreads();
    const XcdBarrier xbar = xcd_barrier_post((unsigned*)ws, MISC + 8);
    if (tid == 0) __hip_atomic_store((unsigned*)(ws + 24576) + blockIdx.x, xb_xcc_id() + 1u, __ATOMIC_RELAXED, __HIP_MEMORY_SCOPE_AGENT);
#define SYNC(k) do { xcd_barrier(xbar); } while (0)
    if (hi > 1000) grid.sync();
#endif
#ifndef REP_MASK
#define REP_MASK 0
#endif
#define NREP(k) (((REP_MASK >> (k)) & 1) ? 2 : 1)
    const int G = gridDim.x, c = blockIdx.x;
    if (IN(0)) for (int rep = 0; rep < NREP(0); ++rep) { phase0(p, lds, wv, lane); SYNC(0); }
    if (IN(1)) for (int rep = 0; rep < NREP(1); ++rep) {
        pg8::Gemm g{(const bf16_t*)(ws + WS_HN), (const bf16_t*)(ws + WS_WIN), 2048, 2048, 2048, 0}; pg8::StaticOrder S; S.init(RP, NIN, G, c);
        pg8::EpiIn E{(bf16_t*)(ws + WS_QKV), (bf16_t*)(ws + WS_Z), (bf16_t*)(ws + WS_P), (unsigned char*)(ws + WS_GAB), (float*)(ws + WS_BA)};
        pg8::gemm_phase(lds, g, S, E);
        const int wc_ = (G == 256) ? ((c >= (65 * 37) % 256 && c < (65 * 37) % 256 + 32) ? c - (65 * 37) % 256 : -1) : c;
        if (wc_ >= 0) {
            pg8::Gemm g2{(const bf16_t*)(ws + WS_WB), (const bf16_t*)(ws + WS_POOLT), 1024, 256, 256, 256}; pg8::StaticOrder S; S.init(2048, 1024, G, wc_);
            pg8::EpiPlain E2{(bf16_t*)(ws + WS_WEFF), 1024};
            pg8::gemm_phase(lds, g2, S, E2); }
        { constexpr int NFULL = (65 * 37) % 256; if (G == 256 && c >= NFULL) convert_weights<true>(p, lds, wv, lane, NFULL, 256 - NFULL); else if (G != 256) convert_weights<true>(p, lds, wv, lane, 0, G); }
        SYNC(1); }
    if (IN(2) && IN(3)) {
        f32x4 sacc = (f32x4){0.f, 0.f, 0.f, 0.f};
        const bool split = (G == 256);
        const int nst = split ? 4 : 2;
        for (int st = 0; st < nst; ++st) {
            int plo, phi, slo, shi;
            if (split) { plo = st == 0 ? 0 : (st == 1 ? 96 : (st == 2 ? 128 : NCH)); phi = st == 0 ? 96 : (st == 1 ? 128 : NCH);
                         slo = st <= 1 ? 0 : (st == 2 ? 96 : 128); shi = st == 0 ? 0 : (st == 1 ? 96 : (st == 2 ? 128 : NCH)); }
            else { plo = st == 0 ? 0 : NCH; phi = NCH; slo = 0; shi = st == 0 ? 0 : NCH; }
            const bool scanner = (c < 128) && (st > 0);
            const bool all_prep = !split || st == 0;
            if (scanner) { if (slo < shi) scan_run(p, lds, wv, lane, sacc, slo, shi, slo == 0); }
            else if (plo < phi) prep_phase(p, lds, wv, lane, plo, phi, all_prep ? c : c - 128, all_prep ? G : 128);
            SYNC(2);
        }
    }
    if (IN(4)) for (int rep = 0; rep < NREP(4); ++rep) { phase4(p, lds, wv, lane); SYNC(4); }
    const bool teams = (G == 256);
    unsigned tgen = 0u; unsigned* tctr = (unsigned*)(ws + 16384) + (c & 63) * 16;
    bool team_same_xcc = false;
    if (teams && IN(6)) { unsigned* tab = (unsigned*)(ws + 24576) + (c & 63); const unsigned x0 = xb_ld(tab), x1 = xb_ld(tab + 64), x2 = xb_ld(tab + 128), x3 = xb_ld(tab + 192);
        team_same_xcc = (x0 != 0u) && (x0 == x1) && (x1 == x2) && (x2 == x3); }
    const int team_pm = 8 * (c & 7) + ((c >> 3) & 7);
#define TSYNC(k) do { if (teams) team_barrier(tctr, tgen, team_same_xcc); else xcd_barrier(xbar); } while (0)
    if (teams && IN(6)) { for (int k = 0; k < ((c >> 3) & 7); ++k) __builtin_amdgcn_s_sleep(100); }
    if (IN(6)) for (int rep = 0; rep < NREP(6); ++rep) {
        pg8::StaticOrder S; S.init(RR, 2048, G, c);
        { pg8::Gemm g{(const bf16_t*)(ws + WS_OG), (const bf16_t*)(ws + WS_WA), 1024, 1024, 1024, 0};
          pg8::EpiMerge<false> E{(const unsigned char*)(ws + WS_GAB), (bf16_t*)(ws + WS_MERGED)}; pg8::gemm_phase(lds, g, S, E); }
        { pg8::Gemm g{(const bf16_t*)(ws + WS_POOLED), (const bf16_t*)(ws + WS_WEFF), 1024, 1024, 1024, 0};
          pg8::EpiMerge<true> E{(const unsigned char*)(ws + WS_GAB), (bf16_t*)(ws + WS_MERGED)}; pg8::gemm_phase(lds, g, S, E); }
        TSYNC(6); }
    if (IN(7)) for (int rep = 0; rep < NREP(7); ++rep) {
        pg8::Gemm g{(const bf16_t*)(ws + WS_MERGED), (const bf16_t*)(ws + WS_WOUT), 2048, 2048, 2048, 0}; pg8::StaticOrder S; S.init(RR, 2048, G, c);
        pg8::EpiOut E{p.x, (bf16_t*)(ws + WS_H1B), (float*)(ws + WS_SS1)};
        pg8::gemm_phase(lds, g, S, E); TSYNC(7); }
    if (IN(8)) for (int rep = 0; rep < NREP(8); ++rep) {
        pg8::Gemm g{(const bf16_t*)(ws + WS_H1B), (const bf16_t*)(ws + WS_WGU), 2048, 2048, 2048, 0}; pg8::StaticOrder S; S.init(RR, 2 * FFN, G, c);
        pg8::Unit u0; const bool has0 = S.next(0, u0); const int pm0 = has0 ? u0.pm : -1;
        LAS float* RS = (LAS float*)(lds + 135168);
        if (has0 && tid < 256) { const f32x4* sp = (const f32x4*)((const float*)(ws + WS_SS1) + (size_t)(pm0 * 256 + tid) * 32); float ss = 0.f;
#pragma unroll
            for (int i = 0; i < 8; ++i) { const f32x4 q = sp[i]; ss += (q[0] + q[1]) + (q[2] + q[3]); }
            RS[tid] = __builtin_amdgcn_rsqf(ss * (1.0f / 2048.0f) + RMS_EPS); }
        __syncthreads();
        pg8::EpiGU E{(const float*)(ws + WS_SS1), (bf16_t*)(ws + WS_HIDDEN), RS, pm0};
        pg8::gemm_phase(lds, g, S, E); TSYNC(8); }
    if (IN(9)) {
        pg8::Gemm g{(const bf16_t*)(ws + WS_HIDDEN), (const bf16_t*)(ws + WS_WD), FFN, FFN, FFN, 0}; pg8::StaticOrder S; S.init(RR, 2048, G, c);
        pg8::EpiDown E{(const bf16_t*)(ws + WS_H1B), (bf16_t*)(ws + WS_H2B)};
        pg8::gemm_phase(lds, g, S, E); TSYNC(9); }
    if (IN(10)) { if (teams) final_phase(p, wv, lane, team_pm * 256, team_pm * 256 + 256, (c >> 6) * 8 + wv, 32); else final_phase(p, wv, lane, 0, RR, c * 8 + wv, G * 8); }
#ifdef DIGEST_OFF
    if (lo <= 11 && 11 < hi) {
        const bf16_t* src = (const bf16_t*)(ws + (size_t)DIGEST_OFF * MiB);
        for (size_t i = (size_t)blockIdx.x * NTHREADS + tid; i < (size_t)RR * D; i += (size_t)gridDim.x * NTHREADS)
            p.out[i] = __uint_as_float((unsigned)src[(i * DIGEST_STRIDE) % (size_t)DIGEST_N] << 16);
    }
#endif
#undef IN
#undef SYNC
}

extern "C" void kernel_launch(void* const* d_in, const int* in_sizes, int n_in, void* d_out, int out_size, void* d_ws, size_t ws_size, hipStream_t stream) {
    static int grid = 0;
    if (grid == 0) {
        if (n_in != 18 || ws_size < WS_END) { fprintf(stderr, "kernel_launch: unexpected n_in %d or ws_size %zu\n", n_in, ws_size); grid = -1; return; }
        int dev = 0, cus = 0, per_cu = 0;
        hipGetDevice(&dev); hipDeviceGetAttribute(&cus, hipDeviceAttributeMultiprocessorCount, dev);
        if (hipFuncSetAttribute((const void*)fwd_kernel, hipFuncAttributeMaxDynamicSharedMemorySize, LDS_BYTES) != hipSuccess) { fprintf(stderr, "kernel_launch: hipFuncSetAttribute failed\n"); grid = -1; return; }
        hipOccupancyMaxActiveBlocksPerMultiprocessor(&per_cu, (const void*)fwd_kernel, NTHREADS, LDS_BYTES);
        (void)hipGetLastError();
        if (per_cu < 1) { fprintf(stderr, "kernel_launch: occupancy query says %d blocks per CU\n", per_cu); }
        grid = cus;
    }
    if (grid < 0) return;
    Params p{};
    p.x = (const float*)d_in[0]; p.meta = (const float*)d_in[1]; p.norm_mix_w = (const float*)d_in[2]; p.w_in = (const float*)d_in[3]; p.conv_w = (const float*)d_in[4];
    p.a_log = (const float*)d_in[5]; p.dt_bias = (const float*)d_in[6]; p.o_norm_w = (const float*)d_in[7]; p.w_proj_a = (const float*)d_in[8]; p.pool_w = (const float*)d_in[9];
    p.pool_scale = (const float*)d_in[10]; p.w_proj_b = (const float*)d_in[11]; p.w_out = (const float*)d_in[12]; p.norm_ffn_w = (const float*)d_in[13]; p.w_gate = (const float*)d_in[14];
    p.w_up = (const float*)d_in[15]; p.w_down = (const float*)d_in[16]; p.norm_final_w = (const float*)d_in[17];
    p.out = (float*)d_out; p.ws = (unsigned char*)d_ws;
#if MK_MULTI
    for (int ph = 0; ph <= 11; ++ph) { p.phase_lo = ph; p.phase_hi = ph + 1; hipLaunchKernelGGL(fwd_kernel, dim3(grid), dim3(NTHREADS), LDS_BYTES, stream, p); }
#else
    p.phase_lo = 0; p.phase_hi = 12;
    if (hipMemsetAsync(d_ws, 0, 32768, stream) != hipSuccess) { fprintf(stderr, "kernel_launch: memset of the barrier words failed\n"); return; }
    void* args[] = {&p};
    hipError_t e = hipLaunchCooperativeKernel((const void*)fwd_kernel, dim3(grid), dim3(NTHREADS), args, LDS_BYTES, stream);
    if (e != hipSuccess) fprintf(stderr, "cooperative launch failed: %s (grid %d)\n", hipGetErrorString(e), grid);
#endif
}
```

```cpp
#include <hip/hip_runtime.h>
#include <hip/hip_cooperative_groups.h>
#include <cstdio>
#include <cstdint>
namespace cg = cooperative_groups;

#define LAS __attribute__((address_space(3)))
typedef unsigned short bf16_t;
typedef short bf16x8 __attribute__((ext_vector_type(8)));
typedef float f32x4 __attribute__((ext_vector_type(4)));
typedef float f32x2 __attribute__((ext_vector_type(2)));
typedef unsigned u32x4 __attribute__((ext_vector_type(4)));
typedef unsigned u32x2 __attribute__((ext_vector_type(2)));

#ifndef MK_MULTI
#define MK_MULTI 0
#endif

constexpr int D = 2048, SEQ = 8192, NMETA = 16, TB = 8256  , RPV = 2 * TB  , RP = 16640  , RR = 16384;
constexpr int NCH = 129, NH = 8, HD = 128, NUNIT = 2 * NCH * NH  , UNIT_EL = 36864;
constexpr int FFN = 5632, NIN = 9472;
constexpr float RMS_EPS = 1e-6f, L2_EPS = 1e-6f;
constexpr int NTHREADS = 512;
constexpr int LDS_BYTES = 147456;

constexpr size_t MiB = 1u << 20;
constexpr size_t WS_BA = 1 * MiB, WS_GL = 2 * MiB + 512 * 1024, WS_SS1 = 3 * MiB;
constexpr size_t WS_WIN = 8 * MiB, WS_WA = 45 * MiB, WS_WB = 49 * MiB, WS_POOLT = 53 * MiB;
constexpr size_t WS_WOUT = 54 * MiB, WS_WGU = 62 * MiB, WS_WD = 106 * MiB;
constexpr size_t WS_PREPB = 128 * MiB;
constexpr size_t WS_HN = 128 * MiB, WS_QKV = 200 * MiB, WS_Z = 298 * MiB, WS_P = 331 * MiB, WS_GAB = 364 * MiB;
constexpr size_t WS_O = 200 * MiB, WS_OG = 233 * MiB, WS_POOLED = 266 * MiB, WS_ZB = 128 * MiB, WS_MERGED = 160 * MiB, WS_H1B = 364 * MiB, WS_HIDDEN = 128 * MiB;
constexpr size_t WS_H2B = 428 * MiB;
constexpr size_t WS_WEFF = 494 * MiB;
constexpr size_t WS_END = 498 * MiB;
static_assert(WS_PREPB + (size_t)NUNIT * 12288 * 2 <= WS_QKV && (size_t)NUNIT * 24576 * 2 <= (size_t)RR * D * 4, "prep records");
static_assert(WS_GAB + (size_t)RP * 4096 * 2 <= WS_END, "gab");
static_assert(WS_HIDDEN + (size_t)RR * FFN * 2 <= WS_H1B, "hidden");

struct Params {
    const float* x; const float* meta; const float* norm_mix_w; const float* w_in; const float* conv_w; const float* a_log; const float* dt_bias; const float* o_norm_w;
    const float* w_proj_a; const float* pool_w; const float* pool_scale; const float* w_proj_b; const float* w_out; const float* norm_ffn_w; const float* w_gate; const float* w_up;
    const float* w_down; const float* norm_final_w;
    float* out; unsigned char* ws;
    long long phase_lo, phase_hi;
};

typedef __bf16 bf16x2_t __attribute__((ext_vector_type(2)));
__device__ __forceinline__ unsigned cvt_pk_bf16(float lo, float hi) { const f32x2 v = {lo, hi}; const bf16x2_t b = __builtin_convertvector(v, bf16x2_t); return __builtin_bit_cast(unsigned, b); }
__device__ __forceinline__ float bf_lo(unsigned w) { return __uint_as_float(w << 16); }
__device__ __forceinline__ float bf_hi(unsigned w) { return __uint_as_float(w & 0xffff0000u); }
__device__ __forceinline__ float fast_sigmoid(float x) { return __builtin_amdgcn_rcpf(1.0f + __expf(-x)); }
__device__ __forceinline__ float fast_silu(float x) { return x * fast_sigmoid(x); }
__device__ __forceinline__ float wave_sum(float v) {
#pragma unroll
    for (int o = 1; o < 64; o <<= 1) v += __shfl_xor(v, o);
    return v;
}
#define LDS_WAIT() asm volatile("s_waitcnt lgkmcnt(0)" ::: "memory")

namespace pg8 {
constexpr int BM = 256, BK = 64, HALF = 128, HTB = HALF * BK * 2, STAGE_BYTES = 8 * HTB, NXCD = 8, WGM = 8;
__host__ __device__ __forceinline__ int lds_byte(int r, int c) { const int st = (r >> 4) * 2 + (c >> 5), rr = r & 15, cc = c & 31, ob = rr * 64 + cc * 2; return st * 1024 + (ob ^ (((ob >> 9) & 1) << 5)); }
__host__ __device__ __forceinline__ void stage_rc(int b, int& R, int& C) { const int st = b / 1024, sb = b % 1024, swz = sb ^ (((sb >> 9) & 1) << 5); R = (st >> 1) * 16 + swz / 64; C = (st & 1) * 32 + (swz % 64) / 2; }
__host__ __device__ __forceinline__ int perm32(int rho) { const int n = rho >> 4, i = rho & 15; return 8 * (i >> 2) + 4 * n + (i & 3); }

struct Unit { int pm, pn; };
struct Gemm { const bf16_t* A; const bf16_t* Bt; int lda, ldb, K, a_pn_off; };

struct StaticOrder {
    int nM, nN, nwg, G, c;
    __device__ void init(int M, int N, int G_, int c_) { nM = M / BM; nN = N / BM; nwg = nM * nN; G = G_; c = c_; }
    __device__ bool next(int i, Unit& u) const {
        const long L = (long)i * G + c; if (L >= nwg) return false;
        int wgid = (int)L; { const int q = nwg / NXCD, r = nwg % NXCD, xcd = wgid % NXCD, off = wgid / NXCD; wgid = (xcd < r ? xcd * (q + 1) : r * (q + 1) + (xcd - r) * q) + off; }
        const int nig = WGM * nN, gid = wgid / nig, fm = gid * WGM, gsz = (nM - fm) < WGM ? (nM - fm) : WGM;
        u.pm = fm + ((wgid % nig) % gsz); u.pn = (wgid % nig) / gsz; return true;
    }
};

template <class Epi>
__device__ __forceinline__ void gemm_phase(LAS unsigned char* lds, const Gemm g, const StaticOrder& S, const Epi& E) {
    const int tid = threadIdx.x, wid = __builtin_amdgcn_readfirstlane(tid >> 6), lane = tid & 63, wr = wid >> 2, wc = wid & 3, fr = lane & 15, fq = lane >> 4;
    const int nt = g.K / BK;
    unsigned voffA[2], voffB[2];
#pragma unroll
    for (int i = 0; i < 2; ++i) { int R, C; stage_rc(tid * 16 + i * 8192, R, C); const int Rb = (R & ~31) + perm32(R & 31);
        voffA[i] = (unsigned)(R * g.lda + C) * 2u; voffB[i] = (unsigned)(Rb * g.ldb + C) * 2u; }
    const size_t kstep = (size_t)(BK * 2);
    const size_t hstepA = (size_t)HALF * g.lda * 2, hstepB = (size_t)HALF * g.ldb * 2;
    const unsigned ldsw = (unsigned)wid * 1024u;
    const int aoff = lds_byte(wr * 64 + fr, fq * 8), boff = lds_byte(wc * 32 + fr, fq * 8);
#define PG8_SA(b, h) (((b) * 2 + (h)) * HTB)
#define PG8_SB(b, h) ((4 + (b) * 2 + (h)) * HTB)
#define PG8_STAGE(bufoff, gbase, voff) do { _Pragma("unroll") for (int _i = 0; _i < 2; ++_i) \
        __builtin_amdgcn_global_load_lds((const unsigned*)((const char*)(gbase) + (voff)[_i]), (LAS unsigned*)(lds + (bufoff) + ldsw + _i * 8192), 16, 0, 0); } while (0)
#define PG8_LDA(dst, b, h) do { _Pragma("unroll") for (int m = 0; m < 4; ++m) _Pragma("unroll") for (int k = 0; k < 2; ++k) dst[m][k] = *(const LAS bf16x8*)(lds + PG8_SA(b, h) + aoff + m * 2048 + k * 1024); } while (0)
#define PG8_LDB(dst, b, h) do { _Pragma("unroll") for (int n = 0; n < 2; ++n) _Pragma("unroll") for (int k = 0; k < 2; ++k) dst[n][k] = *(const LAS bf16x8*)(lds + PG8_SB(b, h) + boff + n * 2048 + k * 1024); } while (0)
#define PG8_MMA(ai, bj, At, Bt) do { __builtin_amdgcn_s_setprio(1); _Pragma("unroll") for (int m = 0; m < 4; ++m) _Pragma("unroll") for (int n = 0; n < 2; ++n) _Pragma("unroll") for (int k = 0; k < 2; ++k) \
        acc[ai][bj][m][n] = __builtin_amdgcn_mfma_f32_16x16x32_bf16(Bt[n][k], At[m][k], acc[ai][bj][m][n], 0, 0, 0); __builtin_amdgcn_s_setprio(0); } while (0)
#define PG8_WAIT_V(n) asm volatile("s_waitcnt vmcnt(" #n ")" ::: "memory")
#define PG8_WAIT_L(n) asm volatile("s_waitcnt lgkmcnt(" #n ")" ::: "memory")
#define PG8_BAR __builtin_amdgcn_s_barrier()
#define PG8_SCHED __builtin_amdgcn_sched_barrier(0)
    Unit cur, nxt; int ui = 0;
    if (!S.next(0, cur)) return;
    f32x4 acc[2][2][4][2];
#pragma unroll
    for (int a = 0; a < 2; ++a)
#pragma unroll
        for (int b = 0; b < 2; ++b)
#pragma unroll
            for (int m = 0; m < 4; ++m)
#pragma unroll
                for (int n = 0; n < 2; ++n) acc[a][b][m][n] = (f32x4){0.f, 0.f, 0.f, 0.f};
    bf16x8 At[4][2], B0[2][2], B1[2][2];
    const char* cA = (const char*)g.A + (size_t)cur.pm * 2 * hstepA + (size_t)cur.pn * g.a_pn_off * 2; const char* cB = (const char*)g.Bt + (size_t)cur.pn * 2 * hstepB;
    PG8_STAGE(PG8_SB(0, 0), cB, voffB); PG8_STAGE(PG8_SB(0, 1), cB + hstepB, voffB); PG8_STAGE(PG8_SA(0, 0), cA, voffA); PG8_STAGE(PG8_SA(0, 1), cA + hstepA, voffA);
    if (wr == 1) PG8_BAR;
    PG8_WAIT_V(2); PG8_BAR;
    PG8_STAGE(PG8_SB(1, 0), cB + kstep, voffB); PG8_STAGE(PG8_SA(1, 0), cA + kstep, voffA); PG8_STAGE(PG8_SB(1, 1), cB + hstepB + kstep, voffB);
    PG8_WAIT_V(6); PG8_BAR;
    for (;;) {
        const bool has_next = S.next(ui + 1, nxt);
        const char* nA = has_next ? (const char*)g.A + (size_t)nxt.pm * 2 * hstepA + (size_t)nxt.pn * g.a_pn_off * 2 : cA; const char* nB = has_next ? (const char*)g.Bt + (size_t)nxt.pn * 2 * hstepB : cB;
#pragma unroll 1
        for (int t = 0; t < nt; t += 2) {
            const bool last = (t == nt - 2);
            const char* a1 = cA + (size_t)(t + 1) * kstep;
            const char* a2 = last ? nA : cA + (size_t)(t + 2) * kstep; const char* b2 = last ? nB : cB + (size_t)(t + 2) * kstep;
            const char* a3 = a2 + kstep; const char* b3 = b2 + kstep;
            PG8_LDB(B0, 0, 0); PG8_LDB(B1, 0, 1); PG8_SCHED; PG8_LDA(At, 0, 0); PG8_STAGE(PG8_SA(1, 1), a1 + hstepA, voffA);
            PG8_WAIT_V(8); PG8_WAIT_L(0); PG8_BAR; PG8_MMA(0, 0, At, B0); PG8_MMA(0, 1, At, B1); PG8_BAR; PG8_SCHED;
            PG8_LDA(At, 0, 1); PG8_STAGE(PG8_SB(0, 0), b2, voffB); PG8_STAGE(PG8_SB(0, 1), b2 + hstepB, voffB); PG8_STAGE(PG8_SA(0, 0), a2, voffA);
            PG8_WAIT_V(8); PG8_WAIT_L(0); PG8_BAR; PG8_MMA(1, 0, At, B0); PG8_MMA(1, 1, At, B1); PG8_BAR; PG8_SCHED;
            PG8_LDB(B0, 1, 0); PG8_LDB(B1, 1, 1); PG8_SCHED; PG8_LDA(At, 1, 0); PG8_STAGE(PG8_SA(0, 1), a2 + hstepA, voffA);
            PG8_WAIT_V(8); PG8_WAIT_L(0); PG8_BAR; PG8_MMA(0, 0, At, B0); PG8_MMA(0, 1, At, B1); PG8_BAR; PG8_SCHED;
            PG8_LDA(At, 1, 1); PG8_STAGE(PG8_SB(1, 0), b3, voffB); PG8_STAGE(PG8_SB(1, 1), b3 + hstepB, voffB); PG8_STAGE(PG8_SA(1, 0), a3, voffA);
            PG8_WAIT_V(8); PG8_WAIT_L(0); PG8_BAR; PG8_MMA(1, 0, At, B0); PG8_MMA(1, 1, At, B1); PG8_BAR; PG8_SCHED;
        }
        if (wr == 0) PG8_BAR;
        E(acc, cur, wr, wc, fr, fq);
        if (!has_next) break;
#pragma unroll
        for (int a = 0; a < 2; ++a)
#pragma unroll
            for (int b = 0; b < 2; ++b)
#pragma unroll
                for (int m = 0; m < 4; ++m)
#pragma unroll
                    for (int n = 0; n < 2; ++n) acc[a][b][m][n] = (f32x4){0.f, 0.f, 0.f, 0.f};
        cur = nxt; cA = nA; cB = nB; ++ui;
        if (wr == 1) PG8_BAR;
    }
    PG8_WAIT_V(0);
    PG8_BAR;
#undef PG8_SA
#undef PG8_SB
#undef PG8_STAGE
#undef PG8_LDA
#undef PG8_LDB
#undef PG8_MMA
#undef PG8_WAIT_V
#undef PG8_WAIT_L
#undef PG8_BAR
#undef PG8_SCHED
}

typedef f32x4 AccT[2][2][4][2];
template <int ACT  >
__device__ __forceinline__ void store_tile_bf16(const AccT& acc, bf16_t* base  , int ld, int row0) {
#pragma unroll
    for (int ai = 0; ai < 2; ++ai)
#pragma unroll
        for (int m = 0; m < 4; ++m) { bf16_t* rowp = base + (size_t)(row0 + ai * HALF + m * 16) * ld;
#pragma unroll
            for (int bj = 0; bj < 2; ++bj) { f32x4 v0 = acc[ai][bj][m][0], v1 = acc[ai][bj][m][1];
                if (ACT == 1) { for (int i = 0; i < 4; ++i) { v0[i] = fast_silu(v0[i]); v1[i] = fast_silu(v1[i]); } }
                if (ACT == 2) { for (int i = 0; i < 4; ++i) { v0[i] = fast_sigmoid(v0[i]); v1[i] = fast_sigmoid(v1[i]); } }
                u32x4 w; w.x = cvt_pk_bf16(v0[0], v0[1]); w.y = cvt_pk_bf16(v0[2], v0[3]); w.z = cvt_pk_bf16(v1[0], v1[1]); w.w = cvt_pk_bf16(v1[2], v1[3]);
                *(u32x4*)(rowp + bj * HALF) = w; } }
}
__device__ __forceinline__ unsigned q8(float x) { return (unsigned)(fast_sigmoid(x) * 255.0f + 0.5f); }
__device__ __forceinline__ void store_tile_gate_u8(const AccT& acc, unsigned char* base  , int row0) {
#pragma unroll
    for (int ai = 0; ai < 2; ++ai)
#pragma unroll
        for (int m = 0; m < 4; ++m) { unsigned char* rowp = base + (size_t)(row0 + ai * HALF + m * 16) * 4096;
#pragma unroll
            for (int bj = 0; bj < 2; ++bj) { const f32x4 v0 = acc[ai][bj][m][0], v1 = acc[ai][bj][m][1];
                u32x2 w; w.x = q8(v0[0]) | (q8(v0[1]) << 8) | (q8(v0[2]) << 16) | (q8(v0[3]) << 24); w.y = q8(v1[0]) | (q8(v1[1]) << 8) | (q8(v1[2]) << 16) | (q8(v1[3]) << 24);
                *(u32x2*)(rowp + bj * HALF) = w; } }
}
struct EpiIn {
    bf16_t* QKV; bf16_t* Z; bf16_t* P; unsigned char* GAB; float* BA;
    __device__ __forceinline__ void operator()(const AccT& acc, const Unit& u, int wr, int wc, int fr, int fq) const {
        const int pn = u.pn, row0 = u.pm * BM + wr * 64 + fr, cl = wc * 32 + 8 * fq;
        if (pn == 36) {
            if (wc == 0 && fq < 2) {
#pragma unroll
                for (int ai = 0; ai < 2; ++ai)
#pragma unroll
                    for (int m = 0; m < 4; ++m) { float* q = BA + (size_t)(row0 + ai * HALF + m * 16) * 16 + 8 * fq; *(f32x4*)q = acc[ai][0][m][0]; *(f32x4*)(q + 4) = acc[ai][0][m][1]; }
            }
            return;
        }
        if (pn < 12) store_tile_bf16<0>(acc, QKV + pn * 256 + cl, 3072, row0);
        else if (pn < 16) store_tile_bf16<1>(acc, Z + (pn - 12) * 256 + cl, 1024, row0);
        else if (pn < 20) store_tile_bf16<0>(acc, P + (pn - 16) * 256 + cl, 1024, row0);
        else store_tile_gate_u8(acc, GAB + (pn - 20) * 256 + cl, row0);
    }
};
struct EpiPlain {
    bf16_t* O; int ld;
    __device__ __forceinline__ void operator()(const AccT& acc, const Unit& u, int wr, int wc, int fr, int fq) const {
        store_tile_bf16<0>(acc, O + u.pn * 256 + wc * 32 + 8 * fq, ld, u.pm * BM + wr * 64 + fr);
    }
};
template <bool SECOND> struct EpiMerge {
    const unsigned char* GAB; bf16_t* MERGED;
    __device__ __forceinline__ void operator()(const AccT& acc, const Unit& u, int wr, int wc, int fr, int fq) const {
        const int row0 = u.pm * BM + wr * 64 + fr, cl = u.pn * 256 + wc * 32 + 8 * fq;
#pragma unroll
        for (int ai = 0; ai < 2; ++ai)
#pragma unroll
            for (int m = 0; m < 4; ++m) { const int rr = row0 + ai * HALF + m * 16; const int prow = rr + 64 + ((rr >> 13) << 6);
                const unsigned char* gp = GAB + (size_t)prow * 4096 + (SECOND ? 2048 : 0) + cl; bf16_t* mp = MERGED + (size_t)rr * 2048 + cl;
#pragma unroll
                for (int bj = 0; bj < 2; ++bj) { const u32x2 gw = *(const u32x2*)(gp + bj * HALF); const f32x4 v0 = acc[ai][bj][m][0] * (1.0f / 255.0f), v1 = acc[ai][bj][m][1] * (1.0f / 255.0f);
                    float r0 = (float)(gw.x & 0xffu) * v0[0], r1 = (float)((gw.x >> 8) & 0xffu) * v0[1], r2 = (float)((gw.x >> 16) & 0xffu) * v0[2], r3 = (float)(gw.x >> 24) * v0[3];
                    float r4 = (float)(gw.y & 0xffu) * v1[0], r5 = (float)((gw.y >> 8) & 0xffu) * v1[1], r6 = (float)((gw.y >> 16) & 0xffu) * v1[2], r7 = (float)(gw.y >> 24) * v1[3];
                    if (SECOND) { const u32x4 mw = *(const u32x4*)(mp + bj * HALF);
                        r0 += bf_lo(mw.x); r1 += bf_hi(mw.x); r2 += bf_lo(mw.y); r3 += bf_hi(mw.y); r4 += bf_lo(mw.z); r5 += bf_hi(mw.z); r6 += bf_lo(mw.w); r7 += bf_hi(mw.w); }
                    u32x4 w; w.x = cvt_pk_bf16(r0, r1); w.y = cvt_pk_bf16(r2, r3); w.z = cvt_pk_bf16(r4, r5); w.w = cvt_pk_bf16(r6, r7);
                    *(u32x4*)(mp + bj * HALF) = w; } }
    }
};
struct EpiOut {
    const float* x; bf16_t* H1B; float* SS1;
    __device__ __forceinline__ void operator()(const AccT& acc, const Unit& u, int wr, int wc, int fr, int fq) const {
        const int row0 = u.pm * BM + wr * 64 + fr, cl = u.pn * 256 + wc * 32 + 8 * fq;
#pragma unroll
        for (int ai = 0; ai < 2; ++ai)
#pragma unroll
            for (int m = 0; m < 4; ++m) { const int rr = row0 + ai * HALF + m * 16; const size_t off = (size_t)rr * 2048 + cl; float ss = 0.f;
#pragma unroll
                for (int bj = 0; bj < 2; ++bj) { const f32x4 x0 = *(const f32x4*)(x + off + bj * HALF), x1 = *(const f32x4*)(x + off + bj * HALF + 4);
                    const f32x4 h0 = x0 + acc[ai][bj][m][0], h1 = x1 + acc[ai][bj][m][1];
                    ss += (h0[0] * h0[0] + h0[1] * h0[1]) + (h0[2] * h0[2] + h0[3] * h0[3]) + (h1[0] * h1[0] + h1[1] * h1[1]) + (h1[2] * h1[2] + h1[3] * h1[3]);
                    u32x4 w; w.x = cvt_pk_bf16(h0[0], h0[1]); w.y = cvt_pk_bf16(h0[2], h0[3]); w.z = cvt_pk_bf16(h1[0], h1[1]); w.w = cvt_pk_bf16(h1[2], h1[3]);
                    *(u32x4*)(H1B + off + bj * HALF) = w; }
                ss += __shfl_xor(ss, 16); ss += __shfl_xor(ss, 32);
                if (fq == 0) SS1[(size_t)rr * 32 + u.pn * 4 + wc] = ss; }
    }
};
struct EpiGU {
    const float* SS1; bf16_t* HID; const LAS float* RS; int pm0;
    __device__ __forceinline__ void operator()(const AccT& acc, const Unit& u, int wr, int wc, int fr, int fq) const {
        const int row0 = u.pm * BM + wr * 64 + fr, cl = u.pn * 128 + wc * 32 + 8 * fq;
#pragma unroll
        for (int ai = 0; ai < 2; ++ai)
#pragma unroll
            for (int m = 0; m < 4; ++m) { const int rr = row0 + ai * HALF + m * 16; float rstd;
                if (u.pm == pm0) rstd = RS[ai * HALF + wr * 64 + m * 16 + fr];
                else { const f32x4* sp = (const f32x4*)(SS1 + (size_t)rr * 32) + 2 * fq; float ss;
                    { const f32x4 s0 = sp[0], s1 = sp[1]; ss = ((s0[0] + s0[1]) + (s0[2] + s0[3])) + ((s1[0] + s1[1]) + (s1[2] + s1[3])); }
                    ss += __shfl_xor(ss, 16); ss += __shfl_xor(ss, 32);
                    rstd = __builtin_amdgcn_rsqf(ss * (1.0f / 2048.0f) + RMS_EPS); }
                const f32x4 g0 = acc[ai][0][m][0] * rstd, g1 = acc[ai][0][m][1] * rstd, u0 = acc[ai][1][m][0] * rstd, u1 = acc[ai][1][m][1] * rstd;
                u32x4 w; w.x = cvt_pk_bf16(fast_silu(g0[0]) * u0[0], fast_silu(g0[1]) * u0[1]); w.y = cvt_pk_bf16(fast_silu(g0[2]) * u0[2], fast_silu(g0[3]) * u0[3]);
                w.z = cvt_pk_bf16(fast_silu(g1[0]) * u1[0], fast_silu(g1[1]) * u1[1]); w.w = cvt_pk_bf16(fast_silu(g1[2]) * u1[2], fast_silu(g1[3]) * u1[3]);
                *(u32x4*)(HID + (size_t)rr * FFN + cl) = w; }
    }
};
struct EpiDown {
    const bf16_t* H1B; bf16_t* H2B;
    __device__ __forceinline__ void operator()(const AccT& acc, const Unit& u, int wr, int wc, int fr, int fq) const {
        const int row0 = u.pm * BM + wr * 64 + fr, cl = u.pn * 256 + wc * 32 + 8 * fq;
#pragma unroll
        for (int ai = 0; ai < 2; ++ai)
#pragma unroll
            for (int m = 0; m < 4; ++m) { const size_t off = (size_t)(row0 + ai * HALF + m * 16) * 2048 + cl;
#pragma unroll
                for (int bj = 0; bj < 2; ++bj) { const u32x4 hw = *(const u32x4*)(H1B + off + bj * HALF); const f32x4 v0 = acc[ai][bj][m][0], v1 = acc[ai][bj][m][1];
                    u32x4 w; w.x = cvt_pk_bf16(bf_lo(hw.x) + v0[0], bf_hi(hw.x) + v0[1]); w.y = cvt_pk_bf16(bf_lo(hw.y) + v0[2], bf_hi(hw.y) + v0[3]);
                    w.z = cvt_pk_bf16(bf_lo(hw.z) + v1[0], bf_hi(hw.z) + v1[1]); w.w = cvt_pk_bf16(bf_lo(hw.w) + v1[2], bf_hi(hw.w) + v1[3]);
                    *(u32x4*)(H2B + off + bj * HALF) = w; } }
    }
};
}

constexpr int TR_LDS = 64 * 65 * 4;
struct TrDesc { const float* src; bf16_t* dst; const float* kscale; int ldw, ncols, ldk; };
struct TrRegs { f32x4 v[16]; float ks; };
__device__ __forceinline__ void tr_load(const TrDesc& d, TrRegs& R, int lane) {
    const int r4 = lane >> 4, cq = lane & 15;
    const bool on = 4 * cq < d.ncols;
    const float* sp = d.src + (size_t)r4 * d.ldw + (on ? 4 * cq : 0);
#pragma unroll
    for (int it = 0; it < 16; ++it) { const f32x4 x = *(const f32x4*)(sp + (size_t)(4 * it) * d.ldw); R.v[it] = on ? x : (f32x4){0.f, 0.f, 0.f, 0.f}; }
    R.ks = d.kscale ? d.kscale[lane] : 1.0f;
}
__device__ __forceinline__ void tr_finish(const TrDesc& d, const TrRegs& R, LAS float* scr, int lane, bool valid) {
    const int r4 = lane >> 4, cq = lane & 15;
#pragma unroll
    for (int it = 0; it < 16; ++it) { const int kk = 4 * it + r4; const float kv = __shfl(R.ks, kk); const f32x4 v = R.v[it] * kv;
        LAS float* q = scr + kk * 65 + 4 * cq; q[0] = v[0]; q[1] = v[1]; q[2] = v[2]; q[3] = v[3]; }
    LDS_WAIT(); asm volatile("" ::: "memory");
    const int cc = lane & 7;
#pragma unroll
    for (int j = 0; j < 8; ++j) { const int n = (lane >> 3) + 8 * j; const LAS float* sp = scr + (8 * cc) * 65 + n;
        u32x4 o; o.x = cvt_pk_bf16(sp[0 * 65], sp[1 * 65]); o.y = cvt_pk_bf16(sp[2 * 65], sp[3 * 65]); o.z = cvt_pk_bf16(sp[4 * 65], sp[5 * 65]); o.w = cvt_pk_bf16(sp[6 * 65], sp[7 * 65]);
        if (valid) *(u32x4*)(d.dst + (size_t)n * d.ldk + 8 * cc) = o; }
    LDS_WAIT(); asm volatile("" ::: "memory");
}
constexpr int EARLY_ITEMS = 148 * 32 + 32 * 16 + 32 * 16;
__device__ __forceinline__ TrDesc early_desc(const Params& p, int r) {
    unsigned char* ws = p.ws; TrDesc d; d.kscale = nullptr;
    constexpr int I_IN = 148 * 32, I_A = 32 * 16;
    if (r < I_IN) { const int rb = r / 32, kb = r % 32, dst = rb * 64; int src, nc;
        if (dst < 9216) { src = dst + (dst >= 4096 ? 16 : 0); nc = 64; } else if (dst == 9216) { src = 4096; nc = 16; } else { src = 0; nc = 0; }
        d.src = p.w_in + (size_t)(kb * 64) * 9232 + src; d.ldw = 9232; d.ncols = nc; d.dst = (bf16_t*)(ws + WS_WIN) + (size_t)dst * 2048 + kb * 64; d.ldk = 2048; return d; }
    r -= I_IN;
    const bool isb = r >= I_A; if (isb) r -= I_A;
    const int rb = r / 16, kb = r % 16;
    d.src = (isb ? p.w_proj_b : p.w_proj_a) + (size_t)(kb * 64) * 2048 + rb * 64; d.ldw = 2048; d.ncols = 64; d.dst = (bf16_t*)(ws + (isb ? WS_WB : WS_WA)) + (size_t)(rb * 64) * 1024 + kb * 64; d.ldk = 1024; return d;
}
constexpr int LATE_ITEMS = 32 * 32 + 2 * 88 * 32 + 32 * 88;
__device__ __forceinline__ TrDesc late_desc(const Params& p, int r) {
    unsigned char* ws = p.ws; TrDesc d; d.kscale = nullptr;
    constexpr int I_O = 32 * 32, I_G = 88 * 32;
    if (r < I_O) { const int rb = r / 32, kb = r % 32; d.src = p.w_out + (size_t)(kb * 64) * 2048 + rb * 64; d.ldw = 2048; d.ncols = 64; d.dst = (bf16_t*)(ws + WS_WOUT) + (size_t)(rb * 64) * 2048 + kb * 64; d.ldk = 2048; return d; }
    r -= I_O;
    if (r < 2 * I_G) { const bool up = r >= I_G; if (up) r -= I_G; const int rb = r / 32, kb = r % 32, j0 = rb * 64; const int dst = (j0 / 128) * 256 + (j0 % 128) + (up ? 128 : 0);
        d.src = (up ? p.w_up : p.w_gate) + (size_t)(kb * 64) * FFN + j0; d.ldw = FFN; d.ncols = 64; d.dst = (bf16_t*)(ws + WS_WGU) + (size_t)dst * 2048 + kb * 64; d.ldk = 2048; d.kscale = p.norm_ffn_w + kb * 64; return d; }
    r -= 2 * I_G;
    { const int rb = r / 88, kb = r % 88; d.src = p.w_down + (size_t)(kb * 64) * 2048 + rb * 64; d.ldw = 2048; d.ncols = 64; d.dst = (bf16_t*)(ws + WS_WD) + (size_t)(rb * 64) * FFN + kb * 64; d.ldk = FFN; return d; }
}
template <bool LATE>
__device__ __forceinline__ void convert_weights(const Params& p, LAS unsigned char* lds, int wv, int lane, int wg0, int nwg) {
    LAS float* scr = (LAS float*)(lds + wv * TR_LDS);
    const int gw = ((int)blockIdx.x - wg0) * 8 + wv, NGW = nwg * 8;
    constexpr int NI = LATE ? LATE_ITEMS : EARLY_ITEMS;
    const int trips = (NI + NGW - 1) / NGW;
#define TR_DESC(i_) (LATE ? late_desc(p, (i_) < NI ? (i_) : NI - 1) : early_desc(p, (i_) < NI ? (i_) : NI - 1))
    TrDesc d0 = TR_DESC(gw), d1 = TR_DESC(gw + NGW);
    TrRegs r0, r1;
    tr_load(d0, r0, lane); tr_load(d1, r1, lane);
    for (int k = 0; k < trips; k += 2) {
        const int i0 = gw + k * NGW, i1 = i0 + NGW;
        tr_finish(d0, r0, scr, lane, i0 < NI);
        d0 = TR_DESC(i0 + 2 * NGW); tr_load(d0, r0, lane);
        tr_finish(d1, r1, scr, lane, (k + 1 < trips) && i1 < NI);
        d1 = TR_DESC(i1 + 2 * NGW); tr_load(d1, r1, lane);
    }
#undef TR_DESC
}

__device__ __forceinline__ void phase0(const Params& p, LAS unsigned char* lds, int wv, int lane) {
    unsigned char* ws = p.ws;
    const int gw = blockIdx.x * 8 + wv, NGW = gridDim.x * 8;
    convert_weights<false>(p, lds, wv, lane, 0, (int)gridDim.x);
    { bf16_t* PB = (bf16_t*)(ws + WS_POOLT);
      for (int i = blockIdx.x * NTHREADS + threadIdx.x; i < 4 * 256 * 256 / 4; i += gridDim.x * NTHREADS) {
          const int e = 4 * i, g = e >> 16, d = e & 255; const f32x4 v = *(const f32x4*)(p.pool_w + e); const f32x4 sc = *(const f32x4*)(p.pool_scale + g * 256 + d);
          u32x2 o; o.x = cvt_pk_bf16(v[0] * sc[0], v[1] * sc[1]); o.y = cvt_pk_bf16(v[2] * sc[2], v[3] * sc[3]); *(u32x2*)(PB + e) = o; } }
    bf16_t* HN = (bf16_t*)(ws + WS_HN);
    for (int row = gw; row < RP; row += NGW) {
        const float* src = nullptr;
        if (row < RPV) { const int b = row / TB, pos = row - b * TB; if (pos >= 64) src = p.x + (size_t)(b * SEQ + pos - 64) * D; else if (pos >= 48) src = p.meta + (size_t)(pos - 48) * D; }
        u32x2* o8 = (u32x2*)(HN + (size_t)row * D) + lane;
        if (!src) {
#pragma unroll
            for (int j = 0; j < 8; ++j) o8[64 * j] = (u32x2){0u, 0u};
        } else {
            const f32x4* xr = (const f32x4*)src + lane; const f32x4* wr_ = (const f32x4*)p.norm_mix_w + lane;
            f32x4 v[8]; float s = 0.f;
#pragma unroll
            for (int j = 0; j < 8; ++j) { v[j] = __builtin_nontemporal_load(xr + 64 * j); s += (v[j][0] * v[j][0] + v[j][1] * v[j][1]) + (v[j][2] * v[j][2] + v[j][3] * v[j][3]); }
            const float rstd = __builtin_amdgcn_rsqf(wave_sum(s) * (1.0f / D) + RMS_EPS);
#pragma unroll
            for (int j = 0; j < 8; ++j) { const f32x4 w = wr_[64 * j]; u32x2 o; o.x = cvt_pk_bf16(v[j][0] * rstd * w[0], v[j][1] * rstd * w[1]); o.y = cvt_pk_bf16(v[j][2] * rstd * w[2], v[j][3] * rstd * w[3]); o8[64 * j] = o; }
        }
    }
}

__device__ __forceinline__ void prep_phase(const Params& p, LAS unsigned char* lds, int wv, int lane_in, int n_lo, int n_hi, int w, int nw) {
    unsigned char* ws = p.ws;
    LAS float* AM = (LAS float*)(lds);
    LAS bf16_t* TM = (LAS bf16_t*)(lds + 17408);
    LAS bf16_t* QN = (LAS bf16_t*)(lds + 26624);
    LAS bf16_t* KN = (LAS bf16_t*)(lds + 44032);
    LAS bf16_t* KBT = (LAS bf16_t*)(lds + 61440);
    LAS bf16_t* VBT = (LAS bf16_t*)(lds + 79872);
    const bf16_t* QKV = (const bf16_t*)(ws + WS_QKV); const float* BA = (const float*)(ws + WS_BA); float* GL = (float*)(ws + WS_GL);
    const float qscale = 0.08838834764831845f;
    for (int ui = w; ui < (n_hi - n_lo) * 16; ui += nw) {
        const int n = n_lo + (ui >> 4), b = (ui >> 3) & 1, h = ui & 7;
        const int r0 = b * TB + n * 64;
        int lane = lane_in; asm volatile("" : "+v"(lane));
        const int fr = lane & 15, fq = lane >> 4;
        const int urec = (b * NH + h) * NCH + n;
        bf16_t* UA = (bf16_t*)p.out + (size_t)urec * 24576; bf16_t* UB = (bf16_t*)(ws + WS_PREPB) + (size_t)urec * 12288;
        bf16_t* uT = UA; bf16_t* wM = UA + 8192; bf16_t* qd = UA + 16384; bf16_t* kdT = UB; bf16_t* qkM = UB + 8192;
        float beta, gc, gcl;
        { const float bl = BA[(size_t)(r0 + lane) * 16 + h], al = BA[(size_t)(r0 + lane) * 16 + 8 + h];
          const bool valid = !(n == 0 && lane < 48);
          const float xg = al + p.dt_bias[h]; const float sp = fmaxf(xg, 0.f) + log1pf(expf(-fabsf(xg)));
          float g = valid ? -expf(p.a_log[h]) * sp : 0.f;
          beta = valid ? 1.0f / (1.0f + expf(-bl)) : 0.f;
#pragma unroll
          for (int o = 1; o < 64; o <<= 1) { const float t = __shfl_up(g, o); if (lane >= o) g += t; }
          gc = g; gcl = __shfl(gc, 63); }
        {
            const int t0 = wv * 8;
            unsigned xin[3][11]; float cw[3][4][2];
#pragma unroll
            for (int c3 = 0; c3 < 3; ++c3) {
#pragma unroll
                for (int i = 0; i < 11; ++i) { const int grow = r0 + t0 - 3 + i; xin[c3][i] = (grow >= 0) ? *(const unsigned*)(QKV + (size_t)grow * 3072 + c3 * 1024 + h * 128 + 2 * lane) : 0u; }
#pragma unroll
                for (int j = 0; j < 4; ++j) { const f32x2 w2 = *(const f32x2*)(p.conv_w + (size_t)j * 3072 + c3 * 1024 + h * 128 + 2 * lane); cw[c3][j][0] = w2[0]; cw[c3][j][1] = w2[1]; }
            }
            float kb[2][8], vb[2][8], kd[2][8];
            float y[8][3][2], ssq[8], ssk[8];
#pragma unroll
            for (int i = 0; i < 8; ++i) {
#pragma unroll
                for (int c3 = 0; c3 < 3; ++c3) { float a0 = 0.f, a1 = 0.f;
#pragma unroll
                    for (int j = 0; j < 4; ++j) { a0 += cw[c3][j][0] * bf_lo(xin[c3][i + j]); a1 += cw[c3][j][1] * bf_hi(xin[c3][i + j]); }
                    y[i][c3][0] = fast_silu(a0); y[i][c3][1] = fast_silu(a1); }
                ssq[i] = y[i][0][0] * y[i][0][0] + y[i][0][1] * y[i][0][1]; ssk[i] = y[i][1][0] * y[i][1][0] + y[i][1][1] * y[i][1][1];
            }
#pragma unroll
            for (int o = 1; o < 64; o <<= 1) {
#pragma unroll
                for (int i = 0; i < 8; ++i) { ssq[i] += __shfl_xor(ssq[i], o); ssk[i] += __shfl_xor(ssk[i], o); }
            }
#pragma unroll
            for (int i = 0; i < 8; ++i) {
                const int t = t0 + i;
                const float rq = __builtin_amdgcn_rsqf(ssq[i] + L2_EPS) * qscale, rk = __builtin_amdgcn_rsqf(ssk[i] + L2_EPS);
                const float bt = __shfl(beta, t), gct = __shfl(gc, t);
                const float eg = __expf(gct), egl = __expf(gcl - gct);
                const float q0 = y[i][0][0] * rq, q1 = y[i][0][1] * rq, k0 = y[i][1][0] * rk, k1 = y[i][1][1] * rk;
                *(LAS unsigned*)(QN + t * 136 + 2 * lane) = cvt_pk_bf16(q0, q1);
                *(LAS unsigned*)(KN + t * 136 + 2 * lane) = cvt_pk_bf16(k0, k1);
                *(unsigned*)(qd + ((((t >> 4) * 4 + (lane >> 4)) * 64 + ((lane & 15) >> 2) * 16 + (t & 15)) * 8 + 2 * (lane & 3))) = cvt_pk_bf16(q0 * eg, q1 * eg);
                kb[0][i] = k0 * bt * eg; kb[1][i] = k1 * bt * eg; vb[0][i] = y[i][2][0] * bt; vb[1][i] = y[i][2][1] * bt; kd[0][i] = k0 * egl; kd[1][i] = k1 * egl;
            }
#pragma unroll
            for (int ch = 0; ch < 2; ++ch) { const int d = 2 * lane + ch; u32x4 a, v, k;
                a.x = cvt_pk_bf16(kb[ch][0], kb[ch][1]); a.y = cvt_pk_bf16(kb[ch][2], kb[ch][3]); a.z = cvt_pk_bf16(kb[ch][4], kb[ch][5]); a.w = cvt_pk_bf16(kb[ch][6], kb[ch][7]);
                v.x = cvt_pk_bf16(vb[ch][0], vb[ch][1]); v.y = cvt_pk_bf16(vb[ch][2], vb[ch][3]); v.z = cvt_pk_bf16(vb[ch][4], vb[ch][5]); v.w = cvt_pk_bf16(vb[ch][6], vb[ch][7]);
                k.x = cvt_pk_bf16(kd[ch][0], kd[ch][1]); k.y = cvt_pk_bf16(kd[ch][2], kd[ch][3]); k.z = cvt_pk_bf16(kd[ch][4], kd[ch][5]); k.w = cvt_pk_bf16(kd[ch][6], kd[ch][7]);
                *(LAS u32x4*)(KBT + d * 72 + t0) = a; *(LAS u32x4*)(VBT + d * 72 + t0) = v;
                *(u32x4*)(kdT + ((((d >> 4) * 2 + (wv >> 2)) * 64 + (wv & 3) * 16 + (d & 15)) * 8)) = k; }
        }
        __syncthreads();
        {
            const int it = wv >> 1;
#pragma unroll
            for (int jj = 0; jj < 2; ++jj) { const int jt = (wv & 1) * 2 + jj;
                f32x4 akk = (f32x4){0.f, 0.f, 0.f, 0.f}, aqk = (f32x4){0.f, 0.f, 0.f, 0.f};
#pragma unroll
                for (int kk = 0; kk < 4; ++kk) {
                    const bf16x8 kni = *(const LAS bf16x8*)(KN + (it * 16 + fr) * 136 + kk * 32 + fq * 8);
                    const bf16x8 knj = *(const LAS bf16x8*)(KN + (jt * 16 + fr) * 136 + kk * 32 + fq * 8);
                    const bf16x8 qni = *(const LAS bf16x8*)(QN + (it * 16 + fr) * 136 + kk * 32 + fq * 8);
                    akk = __builtin_amdgcn_mfma_f32_16x16x32_bf16(kni, knj, akk, 0, 0, 0);
                    aqk = __builtin_amdgcn_mfma_f32_16x16x32_bf16(knj, qni, aqk, 0, 0, 0);
                }
                { const int j = jt * 16 + fr; const float gj = __shfl(gc, j);
#pragma unroll
                  for (int r = 0; r < 4; ++r) { const int i = it * 16 + fq * 4 + r; const float gi = __shfl(gc, i), bi = __shfl(beta, i);
                      AM[i * 68 + j] = (j < i) ? bi * akk[r] * expf(gi - gj) : 0.f; } }
                { const int i = it * 16 + fr; const float gi = __shfl(gc, i); float v[4];
#pragma unroll
                  for (int r = 0; r < 4; ++r) { const int j = jt * 16 + fq * 4 + r; const float gj = __shfl(gc, j); v[r] = (j <= i) ? aqk[r] * expf(gi - gj) : 0.f; }
                  u32x2 w; w.x = cvt_pk_bf16(v[0], v[1]); w.y = cvt_pk_bf16(v[2], v[3]);
                  *(u32x2*)(qkM + (((it * 2 + (jt >> 1)) * 64 + ((jt & 1) * 2 + (fq >> 1)) * 16 + fr) * 8 + (fq & 1) * 4)) = w; }
            }
        }
        __syncthreads();
        {
            LAS bf16_t* T11T = (LAS bf16_t*)(lds + 98304);
            LAS bf16_t* A21B = (LAS bf16_t*)(lds + 100864);
            LAS bf16_t* XT = (LAS bf16_t*)(lds + 103424);
            if (wv < 2) {
                const int o = wv * 32, c = lane & 31;
                float t[32];
#pragma unroll
                for (int i = 0; i < 32; ++i) {
                    float a0 = (c == i) ? 1.f : 0.f, a1 = 0.f, a2 = 0.f, a3 = 0.f;
#pragma unroll
                    for (int j = 0; j < (i & ~3); j += 4) { const f32x4 av = *(const LAS f32x4*)(AM + (o + i) * 68 + o + j); a0 -= av[0] * t[j]; a1 -= av[1] * t[j + 1]; a2 -= av[2] * t[j + 2]; a3 -= av[3] * t[j + 3]; }
#pragma unroll
                    for (int j = (i & ~3); j < i; ++j) a0 -= AM[(o + i) * 68 + o + j] * t[j];
                    t[i] = (a0 + a1) + (a2 + a3);
                    if (lane < 32) TM[(o + i) * 72 + o + c] = (bf16_t)(cvt_pk_bf16(t[i], 0.f) & 0xffffu);
                    else if (wv == 0) TM[i * 72 + lane] = (bf16_t)0;
                    asm volatile("" ::: "memory");
                }
                if (wv == 0 && lane < 32) {
#pragma unroll
                    for (int q = 0; q < 4; ++q) { u32x4 w; w.x = cvt_pk_bf16(t[8 * q], t[8 * q + 1]); w.y = cvt_pk_bf16(t[8 * q + 2], t[8 * q + 3]); w.z = cvt_pk_bf16(t[8 * q + 4], t[8 * q + 5]); w.w = cvt_pk_bf16(t[8 * q + 6], t[8 * q + 7]);
                        *(LAS u32x4*)(T11T + c * 40 + 8 * q) = w; }
                }
                if (wv == 0 && lane == 0) GL[urec] = expf(gcl);
            } else if (wv < 6) {
                const int e = (wv - 2) * 256 + lane * 4, i = e >> 5, k = e & 31;
                const f32x4 v = *(const LAS f32x4*)(AM + (32 + i) * 68 + k);
                u32x2 w; w.x = cvt_pk_bf16(v[0], v[1]); w.y = cvt_pk_bf16(v[2], v[3]);
                *(LAS u32x2*)(A21B + i * 40 + k) = w;
            }
            __syncthreads();
            const int it2 = (wv >> 1) & 1, jt2 = wv & 1;
            if (wv < 4) {
                const bf16x8 xa = *(const LAS bf16x8*)(A21B + (it2 * 16 + fr) * 40 + fq * 8);
                const bf16x8 yb = *(const LAS bf16x8*)(T11T + (jt2 * 16 + fr) * 40 + fq * 8);
                const f32x4 x = __builtin_amdgcn_mfma_f32_16x16x32_bf16(xa, yb, (f32x4){0.f, 0.f, 0.f, 0.f}, 0, 0, 0);
                u32x2 w; w.x = cvt_pk_bf16(x[0], x[1]); w.y = cvt_pk_bf16(x[2], x[3]);
                *(LAS u32x2*)(XT + (jt2 * 16 + fr) * 40 + it2 * 16 + fq * 4) = w;
            }
            __syncthreads();
            if (wv < 4) {
                const bf16x8 ta = *(const LAS bf16x8*)(TM + (32 + it2 * 16 + fr) * 72 + 32 + fq * 8);
                const bf16x8 xb = *(const LAS bf16x8*)(XT + (jt2 * 16 + fr) * 40 + fq * 8);
                const f32x4 r = __builtin_amdgcn_mfma_f32_16x16x32_bf16(ta, xb, (f32x4){0.f, 0.f, 0.f, 0.f}, 0, 0, 0);
#pragma unroll
                for (int q = 0; q < 4; ++q) TM[(32 + it2 * 16 + fq * 4 + q) * 72 + jt2 * 16 + fr] = (bf16_t)(cvt_pk_bf16(-r[q], 0.f) & 0xffffu);
            }
        }
        __syncthreads();
        {
#pragma unroll
            for (int ct = 0; ct < 4; ++ct) {
                f32x4 au = (f32x4){0.f, 0.f, 0.f, 0.f}, aw = (f32x4){0.f, 0.f, 0.f, 0.f};
#pragma unroll
                for (int kk = 0; kk < 2; ++kk) {
                    const bf16x8 tf = *(const LAS bf16x8*)(TM + (ct * 16 + fr) * 72 + kk * 32 + fq * 8);
                    const bf16x8 vf = *(const LAS bf16x8*)(VBT + (wv * 16 + fr) * 72 + kk * 32 + fq * 8);
                    const bf16x8 kf = *(const LAS bf16x8*)(KBT + (wv * 16 + fr) * 72 + kk * 32 + fq * 8);
                    au = __builtin_amdgcn_mfma_f32_16x16x32_bf16(tf, vf, au, 0, 0, 0);
                    aw = __builtin_amdgcn_mfma_f32_16x16x32_bf16(kf, tf, aw, 0, 0, 0);
                }
                u32x2 w1; w1.x = cvt_pk_bf16(au[0], au[1]); w1.y = cvt_pk_bf16(au[2], au[3]);
                *(u32x2*)(uT + ((wv * 4 + ct) * 64 + lane) * 4) = w1;
                u32x2 w2; w2.x = cvt_pk_bf16(aw[0], aw[1]); w2.y = cvt_pk_bf16(aw[2], aw[3]);
                *(u32x2*)(wM + (((ct * 4 + (wv >> 1)) * 64 + ((wv & 1) * 2 + (fq >> 1)) * 16 + fr) * 8 + (fq & 1) * 4)) = w2;
            }
        }
        __syncthreads();
    }
}

struct ScanRegs { bf16x8 X[4]; bf16x8 Y[2]; bf16x8 KD[2]; u32x2 UU; float gl; };
__device__ __forceinline__ void scan_load(ScanRegs& R, const bf16_t* baseA, const bf16_t* baseB, const float* GL, int unit, int es, int ct, bool roleB, int dt, int lane) {
    const bf16_t* xb = baseA + (roleB ? 16384 : 8192);
#pragma unroll
    for (int kk = 0; kk < 4; ++kk) R.X[kk] = *(const bf16x8*)(xb + ((ct * 4 + kk) * 64 + lane) * 8);
#pragma unroll
    for (int kk = 0; kk < 2; ++kk) R.KD[kk] = *(const bf16x8*)(baseB + ((dt * 2 + kk) * 64 + lane) * 8);
#pragma unroll
    for (int kk = 0; kk < 2; ++kk) R.Y[kk] = *(const bf16x8*)(baseB + 8192 + (roleB ? ((ct * 2 + kk) * 64 + lane) * 8 : 0));
    R.UU = *(const u32x2*)(baseA + (roleB ? 0 : ((es * 4 + ct) * 64 + lane) * 4));
    R.gl = GL[unit];
}
#define LDS_BARRIER() do { asm volatile("s_waitcnt lgkmcnt(0)" ::: "memory"); __builtin_amdgcn_s_barrier(); asm volatile("" ::: "memory"); } while (0)
__device__ __forceinline__ void scan_step(const ScanRegs& cur, f32x4& sacc, LAS bf16_t* SBc, LAS bf16_t* SBn, LAS bf16_t* VN, bf16_t* Orow  , int ct, bool roleB, int dt, int fr, int fq, int hcol) {
    bf16x8 sbf[4];
#pragma unroll
    for (int kk = 0; kk < 4; ++kk) sbf[kk] = *(const LAS bf16x8*)(SBc + fr * 136 + kk * 32 + fq * 8);
    f32x4 a = (f32x4){0.f, 0.f, 0.f, 0.f};
    if (!roleB) {
#pragma unroll
        for (int kk = 0; kk < 4; ++kk) a = __builtin_amdgcn_mfma_f32_16x16x32_bf16(cur.X[kk], sbf[kk], a, 0, 0, 0);
        const float v0 = bf_lo(cur.UU.x) - a[0], v1 = bf_hi(cur.UU.x) - a[1], v2 = bf_lo(cur.UU.y) - a[2], v3 = bf_hi(cur.UU.y) - a[3];
        u32x2 w; w.x = cvt_pk_bf16(v0, v1); w.y = cvt_pk_bf16(v2, v3);
        *(LAS u32x2*)(VN + fr * 72 + ct * 16 + fq * 4) = w;
    } else {
#pragma unroll
        for (int kk = 0; kk < 4; ++kk) a = __builtin_amdgcn_mfma_f32_16x16x32_bf16(sbf[kk], cur.X[kk], a, 0, 0, 0);
    }
    LDS_BARRIER();
    bf16x8 vnf[2];
#pragma unroll
    for (int kk = 0; kk < 2; ++kk) vnf[kk] = *(const LAS bf16x8*)(VN + fr * 72 + kk * 32 + fq * 8);
    sacc = sacc * cur.gl;
#pragma unroll
    for (int kk = 0; kk < 2; ++kk) sacc = __builtin_amdgcn_mfma_f32_16x16x32_bf16(cur.KD[kk], vnf[kk], sacc, 0, 0, 0);
    { u32x2 w; w.x = cvt_pk_bf16(sacc[0], sacc[1]); w.y = cvt_pk_bf16(sacc[2], sacc[3]);
      *(LAS u32x2*)(SBn + fr * 136 + dt * 16 + fq * 4) = w; }
    if (roleB) {
#pragma unroll
        for (int kk = 0; kk < 2; ++kk) a = __builtin_amdgcn_mfma_f32_16x16x32_bf16(vnf[kk], cur.Y[kk], a, 0, 0, 0);
        u32x2 w; w.x = cvt_pk_bf16(a[0], a[1]); w.y = cvt_pk_bf16(a[2], a[3]);
        *(u32x2*)(Orow + (size_t)(ct * 16 + fr) * 1024 + hcol + fq * 4) = w;
    }
    LDS_BARRIER();
}
__device__ __forceinline__ void scan_run(const Params& p, LAS unsigned char* lds, int wv, int lane, f32x4& sacc, int n_lo, int n_hi, bool init) {
    unsigned char* ws = p.ws;
    const int tid = threadIdx.x, fr = lane & 15, fq = lane >> 4;
    const int xcd_ = blockIdx.x & 7, j_ = blockIdx.x >> 3, bh_ = xcd_ * 2 + (j_ >> 3);
    const int b = bh_ >> 3, h = bh_ & 7, es = j_ & 7, e0 = es * 16;
    const int ct = wv & 3, dt = wv; const bool roleB = wv >= 4;
    LAS bf16_t* SB = (LAS bf16_t*)lds;
    LAS bf16_t* VN = (LAS bf16_t*)(lds + 8704);
    const bf16_t* PREPA = (const bf16_t*)p.out; const bf16_t* PREPB = (const bf16_t*)(ws + WS_PREPB); const float* GL = (const float*)(ws + WS_GL); bf16_t* O = (bf16_t*)(ws + WS_O);
    if (init) {
        for (int i = tid; i < 2 * 16 * 136 / 2; i += NTHREADS) ((LAS unsigned*)SB)[i] = 0u;
        __syncthreads();
        sacc = (f32x4){0.f, 0.f, 0.f, 0.f};
    }
    const int ubase = (b * NH + h) * NCH;
    const int hcol = h * 128 + e0;
    bf16_t* Ob = O + (size_t)(b * TB) * 1024;
#define SCAN_LOAD(R, n_) do { const int nn_ = (n_) < n_hi ? (n_) : n_hi - 1; const int unit_ = ubase + nn_; scan_load(R, PREPA + (size_t)unit_ * 24576, PREPB + (size_t)unit_ * 12288, GL, unit_, es, ct, roleB, dt, lane); } while (0)
#define SCAN_STEP(R, n_, SBr, SBw) scan_step(R, sacc, SBr, SBw, VN, Ob + (size_t)((n_) * 64) * 1024, ct, roleB, dt, fr, fq, hcol)
    ScanRegs r0, r1, r2, r3;
    SCAN_LOAD(r0, n_lo); SCAN_LOAD(r1, n_lo + 1); SCAN_LOAD(r2, n_lo + 2);
    LAS bf16_t* SB0 = SB; LAS bf16_t* SB1 = SB + 2176;
    for (int n = n_lo; n < n_hi; n += 4) {
        SCAN_LOAD(r3, n + 3); SCAN_STEP(r0, n, SB0, SB1);
        SCAN_LOAD(r0, n + 4); if (n + 1 < n_hi) SCAN_STEP(r1, n + 1, SB1, SB0);
        SCAN_LOAD(r1, n + 5); if (n + 2 < n_hi) SCAN_STEP(r2, n + 2, SB0, SB1);
        SCAN_LOAD(r2, n + 6); if (n + 3 < n_hi) SCAN_STEP(r3, n + 3, SB1, SB0);
    }
#undef SCAN_LOAD
#undef SCAN_STEP
    asm volatile("s_waitcnt vmcnt(0)" ::: "memory");
    __syncthreads();
}

template <int WIN>
__device__ __forceinline__ void pooled_item(const Params& p, int it, int lane) {
    const bf16_t* P = (const bf16_t*)(p.ws + WS_P); bf16_t* PO = (bf16_t*)(p.ws + WS_POOLED);
    const int rb = it >> 3, cb = it & 7;
    const int rr0 = rb * 16, prow0 = rr0 + 64 + ((rr0 >> 13) << 6);
    const int col = cb * 128 + 2 * lane;
    float v0[15 + WIN], v1[15 + WIN];
#pragma unroll
    for (int k = 0; k < 15 + WIN; ++k) { const unsigned w = *(const unsigned*)(P + (size_t)(prow0 - (WIN - 1) + k) * 1024 + col); v0[k] = bf_lo(w); v1[k] = bf_hi(w); }
    const float inv = 1.0f / (float)WIN;
#pragma unroll
    for (int i = 0; i < 16; ++i) { float a0 = 0.f, a1 = 0.f;
#pragma unroll
        for (int s2 = 0; s2 < WIN; ++s2) { a0 += v0[WIN - 1 + i - s2]; a1 += v1[WIN - 1 + i - s2]; }
        *(unsigned*)(PO + (size_t)(rr0 + i) * 1024 + col) = cvt_pk_bf16(a0 * inv - v0[WIN - 1 + i], a1 * inv - v1[WIN - 1 + i]); }
}

__device__ __forceinline__ void phase4(const Params& p, LAS unsigned char* lds, int wv, int lane) {
    unsigned char* ws = p.ws;
    const int gw = blockIdx.x * 8 + wv, NGW = gridDim.x * 8;
    { const bf16_t* O = (const bf16_t*)(ws + WS_O); const bf16_t* Z = (const bf16_t*)(ws + WS_Z); bf16_t* OG = (bf16_t*)(ws + WS_OG);
      f32x4 nw[4];
#pragma unroll
      for (int i = 0; i < 4; ++i) nw[i] = *(const f32x4*)(p.o_norm_w + (lane & 7) * 16 + 4 * i);
      for (int rr = gw; rr < RR; rr += NGW) {
          const int prow = rr + 64 + ((rr >> 13) << 6);
          const u32x4 o0 = *(const u32x4*)(O + (size_t)prow * 1024 + lane * 16), o1 = *(const u32x4*)(O + (size_t)prow * 1024 + lane * 16 + 8);
          const u32x4 z0 = *(const u32x4*)(Z + (size_t)prow * 1024 + lane * 16), z1 = *(const u32x4*)(Z + (size_t)prow * 1024 + lane * 16 + 8);
          float ov[16], zv[16];
          ov[0] = bf_lo(o0.x); ov[1] = bf_hi(o0.x); ov[2] = bf_lo(o0.y); ov[3] = bf_hi(o0.y); ov[4] = bf_lo(o0.z); ov[5] = bf_hi(o0.z); ov[6] = bf_lo(o0.w); ov[7] = bf_hi(o0.w);
          ov[8] = bf_lo(o1.x); ov[9] = bf_hi(o1.x); ov[10] = bf_lo(o1.y); ov[11] = bf_hi(o1.y); ov[12] = bf_lo(o1.z); ov[13] = bf_hi(o1.z); ov[14] = bf_lo(o1.w); ov[15] = bf_hi(o1.w);
          zv[0] = bf_lo(z0.x); zv[1] = bf_hi(z0.x); zv[2] = bf_lo(z0.y); zv[3] = bf_hi(z0.y); zv[4] = bf_lo(z0.z); zv[5] = bf_hi(z0.z); zv[6] = bf_lo(z0.w); zv[7] = bf_hi(z0.w);
          zv[8] = bf_lo(z1.x); zv[9] = bf_hi(z1.x); zv[10] = bf_lo(z1.y); zv[11] = bf_hi(z1.y); zv[12] = bf_lo(z1.z); zv[13] = bf_hi(z1.z); zv[14] = bf_lo(z1.w); zv[15] = bf_hi(z1.w);
          float ss = 0.f;
#pragma unroll
          for (int i = 0; i < 16; ++i) ss += ov[i] * ov[i];
          ss += __shfl_xor(ss, 1); ss += __shfl_xor(ss, 2); ss += __shfl_xor(ss, 4);
          const float rstd = __builtin_amdgcn_rsqf(ss * (1.0f / 128.0f) + RMS_EPS);
          float r[16];
#pragma unroll
          for (int i = 0; i < 16; ++i) r[i] = ov[i] * rstd * nw[i >> 2][i & 3] * zv[i];
          u32x4 w0, w1; w0.x = cvt_pk_bf16(r[0], r[1]); w0.y = cvt_pk_bf16(r[2], r[3]); w0.z = cvt_pk_bf16(r[4], r[5]); w0.w = cvt_pk_bf16(r[6], r[7]);
          w1.x = cvt_pk_bf16(r[8], r[9]); w1.y = cvt_pk_bf16(r[10], r[11]); w1.z = cvt_pk_bf16(r[12], r[13]); w1.w = cvt_pk_bf16(r[14], r[15]);
          *(u32x4*)(OG + (size_t)rr * 1024 + lane * 16) = w0; *(u32x4*)(OG + (size_t)rr * 1024 + lane * 16 + 8) = w1;
      } }
    for (int it = gw; it < 1024 * 8; it += NGW) {
        const int g = (it & 7) >> 1;
        if (g == 0) pooled_item<2>(p, it, lane); else if (g == 1) pooled_item<4>(p, it, lane); else if (g == 2) pooled_item<8>(p, it, lane); else pooled_item<16>(p, it, lane);
    }
}

__device__ __forceinline__ void final_phase(const Params& p, int wv, int lane, int row_lo, int row_hi, int w, int nw) {
    const int gw = row_lo + w, NGW = nw; const int RRH = row_hi;
    const bf16_t* H2B = (const bf16_t*)(p.ws + WS_H2B);
    for (int rr = gw; rr < RRH; rr += NGW) {
        const u32x4* hr = (const u32x4*)(H2B + (size_t)rr * D) + lane;
        u32x4 h[4]; float s = 0.f;
#pragma unroll
        for (int j = 0; j < 4; ++j) { h[j] = hr[64 * j];
            const float f0 = bf_lo(h[j].x), f1 = bf_hi(h[j].x), f2 = bf_lo(h[j].y), f3 = bf_hi(h[j].y), f4 = bf_lo(h[j].z), f5 = bf_hi(h[j].z), f6 = bf_lo(h[j].w), f7 = bf_hi(h[j].w);
            s += ((f0 * f0 + f1 * f1) + (f2 * f2 + f3 * f3)) + ((f4 * f4 + f5 * f5) + (f6 * f6 + f7 * f7)); }
        const float rstd = __builtin_amdgcn_rsqf(wave_sum(s) * (1.0f / D) + RMS_EPS);
#pragma unroll
        for (int j = 0; j < 4; ++j) { const int e = 8 * (lane + 64 * j); const f32x4 w0 = *(const f32x4*)(p.norm_final_w + e), w1 = *(const f32x4*)(p.norm_final_w + e + 4);
            f32x4 o0, o1; o0[0] = bf_lo(h[j].x) * rstd * w0[0]; o0[1] = bf_hi(h[j].x) * rstd * w0[1]; o0[2] = bf_lo(h[j].y) * rstd * w0[2]; o0[3] = bf_hi(h[j].y) * rstd * w0[3];
            o1[0] = bf_lo(h[j].z) * rstd * w1[0]; o1[1] = bf_hi(h[j].z) * rstd * w1[1]; o1[2] = bf_lo(h[j].w) * rstd * w1[2]; o1[3] = bf_hi(h[j].w) * rstd * w1[3];
            __builtin_nontemporal_store(o0, (f32x4*)(p.out + (size_t)rr * D + e)); __builtin_nontemporal_store(o1, (f32x4*)(p.out + (size_t)rr * D + e + 4)); }
    }
}

#define XB_TMO      128
#define XB_XCNT(j)  (256  + 64 * (j))
#define XB_XSUB(j)  (1280 + 64 * (j))
#define XB_XGEN(j)  (2304 + 64 * (j))
#define XB_TOP      3328
#define XB_TOPGEN   3392
#define XCD_BAR_WORDS 3456
#define XB_SPIN_CAP (1u << 22)
__device__ __forceinline__ unsigned xb_ld(unsigned* p)              { return __hip_atomic_load(p, __ATOMIC_RELAXED, __HIP_MEMORY_SCOPE_AGENT); }
__device__ __forceinline__ unsigned xb_add(unsigned* p, unsigned v) { return __hip_atomic_fetch_add(p, v, __ATOMIC_RELAXED, __HIP_MEMORY_SCOPE_AGENT); }
__device__ __forceinline__ unsigned xb_xcc_id() { return (unsigned)__builtin_amdgcn_s_getreg((3 << 11) | 20) & 0xFu; }
#define XB_SPIN(cond, bar) do { unsigned _sp = 0; while (cond) { __builtin_amdgcn_s_sleep(1); \
    if ((++_sp & 255u) == 0u) { if (xb_ld(&(bar)[XB_TMO])) break; if (_sp > XB_SPIN_CAP) { atomicAdd(&(bar)[XB_TMO], 1u); break; } } } } while (0)
struct XcdBarrier { unsigned* bar; unsigned x; volatile LAS unsigned* st; };
__device__ __forceinline__ XcdBarrier xcd_barrier_post(unsigned* bar, volatile LAS unsigned* st) {
    XcdBarrier b; b.bar = bar; b.x = xb_xcc_id(); b.st = st;
    if (threadIdx.x == 0) (void)xb_add(&bar[XB_XCNT(b.x)], 1u);
    return b;
}
__device__ __forceinline__ void xcd_barrier_complete(unsigned* bar, unsigned x, unsigned& nloc, unsigned& nx) {
    const unsigned G = gridDim.x * gridDim.y * gridDim.z;
    unsigned sum, cnt, mine, sp = 0u;
    for (;;) {
        sum = 0u; cnt = 0u; mine = 0u;
#pragma unroll
        for (unsigned j = 0; j < 16; ++j) { const unsigned c = xb_ld(&bar[XB_XCNT(j)]); sum += c; cnt += (c > 0u) ? 1u : 0u; mine = (j == x) ? c : mine; }
        if (sum == G) break;
        __builtin_amdgcn_s_sleep(1);
        if ((++sp & 255u) == 0u) { if (xb_ld(&bar[XB_TMO])) break; if (sp > XB_SPIN_CAP) { atomicAdd(&bar[XB_TMO], 1u); break; } }
    }
    nloc = mine > 0u ? mine : 1u; nx = cnt > 0u ? cnt : 1u;
}
__device__ __forceinline__ void xcd_barrier(const XcdBarrier& b) {
    asm volatile("s_waitcnt vmcnt(0)" ::: "memory");
    __syncthreads();
    if (threadIdx.x == 0) {
        unsigned* bar = b.bar;
        __builtin_amdgcn_s_waitcnt(0);
        unsigned nloc = b.st[0], nx = b.st[1];
        if (nloc == 0u) { xcd_barrier_complete(bar, b.x, nloc, nx); b.st[0] = nloc; b.st[1] = nx; }
        const unsigned old = xb_add(&bar[XB_XSUB(b.x)], 1u);
        const unsigned gen = old / nloc;
        if (old + 1u == (gen + 1u) * nloc) {
            __builtin_amdgcn_fence(__ATOMIC_RELEASE, "agent");
            asm volatile("s_waitcnt vmcnt(0)" ::: "memory");
            const unsigned og = xb_add(&bar[XB_TOP], 1u);
            const unsigned tg = og / nx;
            if (og + 1u == (tg + 1u) * nx) xb_add(&bar[XB_TOPGEN], 1u);
            else XB_SPIN(xb_ld(&bar[XB_TOPGEN]) == tg, bar);
            __builtin_amdgcn_fence(__ATOMIC_ACQUIRE, "agent");
            xb_add(&bar[XB_XGEN(b.x)], 1u);
            asm volatile("s_waitcnt vmcnt(0)" ::: "memory");
        } else {
            XB_SPIN(xb_ld(&bar[XB_XGEN(b.x)]) == gen, bar);
            __builtin_amdgcn_fence(__ATOMIC_ACQUIRE, "agent");
            asm volatile("s_waitcnt vmcnt(0)" ::: "memory");
        }
    }
    __syncthreads();
}

__device__ __forceinline__ void team_barrier(unsigned* ctr  , unsigned& gen, bool same_xcc  ) {
    asm volatile("s_waitcnt vmcnt(0)" ::: "memory");
    __syncthreads();
    ++gen;
    if (threadIdx.x == 0) {
        if (!same_xcc) __builtin_amdgcn_fence(__ATOMIC_RELEASE, "agent");
        asm volatile("s_waitcnt vmcnt(0)" ::: "memory");
        (void)xb_add(ctr, 1u);
        unsigned sp = 0; const unsigned want = 4u * gen;
        while (xb_ld(ctr) < want) { __builtin_amdgcn_s_sleep(1); if (++sp > XB_SPIN_CAP) break; }
        __builtin_amdgcn_fence(__ATOMIC_ACQUIRE, "agent");
        asm volatile("s_waitcnt vmcnt(0)" ::: "memory");
    }
    __syncthreads();
}

__global__ void __launch_bounds__(NTHREADS, 2) fwd_kernel(Params p) {
    extern __shared__ __attribute__((aligned(16))) unsigned char lds_raw[];
    LAS unsigned char* lds = (LAS unsigned char*)lds_raw;
    const int tid = threadIdx.x, wv = __builtin_amdgcn_readfirstlane(tid >> 6), lane = tid & 63;
    unsigned char* ws = p.ws;
    const int lo = (int)p.phase_lo, hi = (int)p.phase_hi;
#ifndef PH_MASK
#define PH_MASK 0x7ff
#endif
#define IN(k) (((PH_MASK >> (k)) & 1) && lo <= (k) && (k) < hi)
#if MK_MULTI
#define SYNC(k) do { } while (0)
#else
    cg::grid_group grid = cg::this_grid();
    volatile LAS unsigned* MISC = (volatile LAS unsigned*)(lds + LDS_BYTES - 256);
    if (tid < 32) MISC[tid] = 0u;
    __syncthreads();
    const XcdBarrier xbar = xcd_barrier_post((unsigned*)ws, MISC + 8);
    if (tid == 0) __hip_atomic_store((unsigned*)(ws + 24576) + blockIdx.x, xb_xcc_id() + 1u, __ATOMIC_RELAXED, __HIP_MEMORY_SCOPE_AGENT);
#define SYNC(k) do { xcd_barrier(xbar); } while (0)
    if (hi > 1000) grid.sync();
#endif
#ifndef REP_MASK
#define REP_MASK 0
#endif
#define NREP(k) (((REP_MASK >> (k)) & 1) ? 2 : 1)
    const int G = gridDim.x, c = blockIdx.x;
    if (IN(0)) for (int rep = 0; rep < NREP(0); ++rep) { phase0(p, lds, wv, lane); SYNC(0); }
    if (IN(1)) for (int rep = 0; rep < NREP(1); ++rep) {
        pg8::Gemm g{(const bf16_t*)(ws + WS_HN), (const bf16_t*)(ws + WS_WIN), 2048, 2048, 2048, 0}; pg8::StaticOrder S; S.init(RP, NIN, G, c);
        pg8::EpiIn E{(bf16_t*)(ws + WS_QKV), (bf16_t*)(ws + WS_Z), (bf16_t*)(ws + WS_P), (unsigned char*)(ws + WS_GAB), (float*)(ws + WS_BA)};
        pg8::gemm_phase(lds, g, S, E);
        const int wc_ = (G == 256) ? ((c >= (65 * 37) % 256 && c < (65 * 37) % 256 + 32) ? c - (65 * 37) % 256 : -1) : c;
        if (wc_ >= 0) {
            pg8::Gemm g2{(const bf16_t*)(ws + WS_WB), (const bf16_t*)(ws + WS_POOLT), 1024, 256, 256, 256}; pg8::StaticOrder S; S.init(2048, 1024, G, wc_);
            pg8::EpiPlain E2{(bf16_t*)(ws + WS_WEFF), 1024};
            pg8::gemm_phase(lds, g2, S, E2); }
        { constexpr int NFULL = (65 * 37) % 256; if (G == 256 && c >= NFULL) convert_weights<true>(p, lds, wv, lane, NFULL, 256 - NFULL); else if (G != 256) convert_weights<true>(p, lds, wv, lane, 0, G); }
        SYNC(1); }
    if (IN(2) && IN(3)) {
        f32x4 sacc = (f32x4){0.f, 0.f, 0.f, 0.f};
        const bool split = (G == 256);
        const int nst = split ? 4 : 2;
        for (int st = 0; st < nst; ++st) {
            int plo, phi, slo, shi;
            if (split) { plo = st == 0 ? 0 : (st == 1 ? 96 : (st == 2 ? 128 : NCH)); phi = st == 0 ? 96 : (st == 1 ? 128 : NCH);
                         slo = st <= 1 ? 0 : (st == 2 ? 96 : 128); shi = st == 0 ? 0 : (st == 1 ? 96 : (st == 2 ? 128 : NCH)); }
            else { plo = st == 0 ? 0 : NCH; phi = NCH; slo = 0; shi = st == 0 ? 0 : NCH; }
            const bool scanner = (c < 128) && (st > 0);
            const bool all_prep = !split || st == 0;
            if (scanner) { if (slo < shi) scan_run(p, lds, wv, lane, sacc, slo, shi, slo == 0); }
            else if (plo < phi) prep_phase(p, lds, wv, lane, plo, phi, all_prep ? c : c - 128, all_prep ? G : 128);
            SYNC(2);
        }
    }
    if (IN(4)) for (int rep = 0; rep < NREP(4); ++rep) { phase4(p, lds, wv, lane); SYNC(4); }
    const bool teams = (G == 256);
    unsigned tgen = 0u; unsigned* tctr = (unsigned*)(ws + 16384) + (c & 63) * 16;
    bool team_same_xcc = false;
    if (teams && IN(6)) { unsigned* tab = (unsigned*)(ws + 24576) + (c & 63); const unsigned x0 = xb_ld(tab), x1 = xb_ld(tab + 64), x2 = xb_ld(tab + 128), x3 = xb_ld(tab + 192);
        team_same_xcc = (x0 != 0u) && (x0 == x1) && (x1 == x2) && (x2 == x3); }
    const int team_pm = 8 * (c & 7) + ((c >> 3) & 7);
#define TSYNC(k) do { if (teams) team_barrier(tctr, tgen, team_same_xcc); else xcd_barrier(xbar); } while (0)
    if (teams && IN(6)) { for (int k = 0; k < ((c >> 3) & 7); ++k) __builtin_amdgcn_s_sleep(100); }
    if (IN(6)) for (int rep = 0; rep < NREP(6); ++rep) {
        pg8::StaticOrder S; S.init(RR, 2048, G, c);
        { pg8::Gemm g{(const bf16_t*)(ws + WS_OG), (const bf16_t*)(ws + WS_WA), 1024, 1024, 1024, 0};
          pg8::EpiMerge<false> E{(const unsigned char*)(ws + WS_GAB), (bf16_t*)(ws + WS_MERGED)}; pg8::gemm_phase(lds, g, S, E); }
        { pg8::Gemm g{(const bf16_t*)(ws + WS_POOLED), (const bf16_t*)(ws + WS_WEFF), 1024, 1024, 1024, 0};
          pg8::EpiMerge<true> E{(const unsigned char*)(ws + WS_GAB), (bf16_t*)(ws + WS_MERGED)}; pg8::gemm_phase(lds, g, S, E); }
        TSYNC(6); }
    if (IN(7)) for (int rep = 0; rep < NREP(7); ++rep) {
        pg8::Gemm g{(const bf16_t*)(ws + WS_MERGED), (const bf16_t*)(ws + WS_WOUT), 2048, 2048, 2048, 0}; pg8::StaticOrder S; S.init(RR, 2048, G, c);
        pg8::EpiOut E{p.x, (bf16_t*)(ws + WS_H1B), (float*)(ws + WS_SS1)};
        pg8::gemm_phase(lds, g, S, E); TSYNC(7); }
    if (IN(8)) for (int rep = 0; rep < NREP(8); ++rep) {
        pg8::Gemm g{(const bf16_t*)(ws + WS_H1B), (const bf16_t*)(ws + WS_WGU), 2048, 2048, 2048, 0}; pg8::StaticOrder S; S.init(RR, 2 * FFN, G, c);
        pg8::Unit u0; const bool has0 = S.next(0, u0); const int pm0 = has0 ? u0.pm : -1;
        LAS float* RS = (LAS float*)(lds + 135168);
        if (has0 && tid < 256) { const f32x4* sp = (const f32x4*)((const float*)(ws + WS_SS1) + (size_t)(pm0 * 256 + tid) * 32); float ss = 0.f;
#pragma unroll
            for (int i = 0; i < 8; ++i) { const f32x4 q = sp[i]; ss += (q[0] + q[1]) + (q[2] + q[3]); }
            RS[tid] = __builtin_amdgcn_rsqf(ss * (1.0f / 2048.0f) + RMS_EPS); }
        __syncthreads();
        pg8::EpiGU E{(const float*)(ws + WS_SS1), (bf16_t*)(ws + WS_HIDDEN), RS, pm0};
        pg8::gemm_phase(lds, g, S, E); TSYNC(8); }
    if (IN(9)) {
        pg8::Gemm g{(const bf16_t*)(ws + WS_HIDDEN), (const bf16_t*)(ws + WS_WD), FFN, FFN, FFN, 0}; pg8::StaticOrder S; S.init(RR, 2048, G, c);
        pg8::EpiDown E{(const bf16_t*)(ws + WS_H1B), (bf16_t*)(ws + WS_H2B)};
        pg8::gemm_phase(lds, g, S, E); TSYNC(9); }
    if (IN(10)) { if (teams) final_phase(p, wv, lane, team_pm * 256, team_pm * 256 + 256, (c >> 6) * 8 + wv, 32); else final_phase(p, wv, lane, 0, RR, c * 8 + wv, G * 8); }
#ifdef DIGEST_OFF
    if (lo <= 11 && 11 < hi) {
        const bf16_t* src = (const bf16_t*)(ws + (size_t)DIGEST_OFF * MiB);
        for (size_t i = (size_t)blockIdx.x * NTHREADS + tid; i < (size_t)RR * D; i += (size_t)gridDim.x * NTHREADS)
            p.out[i] = __uint_as_float((unsigned)src[(i * DIGEST_STRIDE) % (size_t)DIGEST_N] << 16);
    }
#endif
#undef IN
#undef SYNC
}

extern "C" void kernel_launch(void* const* d_in, const int* in_sizes, int n_in, void* d_out, int out_size, void* d_ws, size_t ws_size, hipStream_t stream) {
    static int grid = 0;
    if (grid == 0) {
        if (n_in != 18 || ws_size < WS_END) { fprintf(stderr, "kernel_launch: unexpected n_in %d or ws_size %zu\n", n_in, ws_size); grid = -1; return; }
        int dev = 0, cus = 0, per_cu = 0;
        hipGetDevice(&dev); hipDeviceGetAttribute(&cus, hipDeviceAttributeMultiprocessorCount, dev);
        if (hipFuncSetAttribute((const void*)fwd_kernel, hipFuncAttributeMaxDynamicSharedMemorySize, LDS_BYTES) != hipSuccess) { fprintf(stderr, "kernel_launch: hipFuncSetAttribute failed\n"); grid = -1; return; }
        hipOccupancyMaxActiveBlocksPerMultiprocessor(&per_cu, (const void*)fwd_kernel, NTHREADS, LDS_BYTES);
        (void)hipGetLastError();
        if (per_cu < 1) { fprintf(stderr, "kernel_launch: occupancy query says %d blocks per CU\n", per_cu); }
        grid = cus;
    }
    if (grid < 0) return;
    Params p{};
    p.x = (const float*)d_in[0]; p.meta = (const float*)d_in[1]; p.norm_mix_w = (const float*)d_in[2]; p.w_in = (const float*)d_in[3]; p.conv_w = (const float*)d_in[4];
    p.a_log = (const float*)d_in[5]; p.dt_bias = (const float*)d_in[6]; p.o_norm_w = (const float*)d_in[7]; p.w_proj_a = (const float*)d_in[8]; p.pool_w = (const float*)d_in[9];
    p.pool_scale = (const float*)d_in[10]; p.w_proj_b = (const float*)d_in[11]; p.w_out = (const float*)d_in[12]; p.norm_ffn_w = (const float*)d_in[13]; p.w_gate = (const float*)d_in[14];
    p.w_up = (const float*)d_in[15]; p.w_down = (const float*)d_in[16]; p.norm_final_w = (const float*)d_in[17];
    p.out = (float*)d_out; p.ws = (unsigned char*)d_ws;
#if MK_MULTI
    for (int ph = 0; ph <= 11; ++ph) { p.phase_lo = ph; p.phase_hi = ph + 1; hipLaunchKernelGGL(fwd_kernel, dim3(grid), dim3(NTHREADS), LDS_BYTES, stream, p); }
#else
    p.phase_lo = 0; p.phase_hi = 12;
    if (hipMemsetAsync(d_ws, 0, 32768, stream) != hipSuccess) { fprintf(stderr, "kernel_launch: memset of the barrier words failed\n"); return; }
    void* args[] = {&p};
    hipError_t e = hipLaunchCooperativeKernel((const void*)fwd_kernel, dim3(grid), dim3(NTHREADS), args, LDS_BYTES, stream);
    if (e != hipSuccess) fprintf(stderr, "cooperative launch failed: %s (grid %d)\n", hipGetErrorString(e), grid);
#endif
}
```
